# Optimizing an MI355X kernel written in HIP

```python
import jax, jax.numpy as jnp
from jax import lax
import numpy as np

D_MODEL = 1024
BATCH = 8
SEQ = 2048
DEPTH = 1
DEC_BATCH = 128
DEC_SEQ = 8
PAST_LEN = 16384
PAGE_SIZE = 128

RET_HEADS = 4
RET_QK_DIM = 128
RET_V_DIM = D_MODEL // 2 // RET_HEADS
RET_WIDTH = RET_HEADS * RET_V_DIM
GLA_HEADS = 4
GLA_V_DIM = D_MODEL // 2 // GLA_HEADS
GLA_QK_DIM = GLA_V_DIM // 2
GLA_WIDTH = GLA_HEADS * GLA_V_DIM
GLA_GATE_RANK = 16
GLA_GATE_NORMALIZER = 16.0
MIX_WIDTH = RET_WIDTH + GLA_WIDTH
D_FF = -(-8 * D_MODEL // (3 * 256)) * 256
IN_SPLITS = (RET_HEADS * RET_QK_DIM, RET_HEADS * RET_QK_DIM, RET_WIDTH, RET_WIDTH,
             GLA_HEADS * GLA_QK_DIM, GLA_HEADS * GLA_QK_DIM, GLA_WIDTH, GLA_WIDTH, GLA_GATE_RANK)
IN_DIM = sum(IN_SPLITS)
RET_CHUNK = 128
GLA_CHUNK = 64
ROPE_BASE = 10000.0
EPS = 1e-6

kernel_name = "hybrid_retention_gla_adaln_step"


def rmsnorm(x, gain):
    xf = x.astype(jnp.float32)
    y = xf * lax.rsqrt(jnp.mean(xf * xf, axis=-1, keepdims=True) + EPS)
    return (y * gain.astype(jnp.float32)).astype(x.dtype)


def rotary(x, pos):
    half = x.shape[-1] // 2
    inv = ROPE_BASE ** (-jnp.arange(half, dtype=jnp.float32) / half)
    ang = pos.astype(jnp.float32)[:, None] * inv[None, :]
    cos, sin = jnp.cos(ang), jnp.sin(ang)
    x1, x2 = x[..., :half], x[..., half:]
    return jnp.concatenate([x1 * cos - x2 * sin, x1 * sin + x2 * cos], axis=-1)


def to_chunks(a, chunk):
    B, H, L, d = a.shape
    return a.reshape(B, H, L // chunk, chunk, d).transpose(2, 0, 1, 3, 4)


def from_chunks(a):
    N, B, H, C, d = a.shape
    return a.transpose(1, 2, 0, 3, 4).reshape(B, H, N * C, d)


def retention_chunked(q, k, v, s0, log_gamma, chunk):
    idx = jnp.arange(chunk, dtype=jnp.float32)
    lg = log_gamma[:, None]
    diff = idx[:, None] - idx[None, :]
    causal = diff >= 0
    decay_mat = jnp.where(causal[None], jnp.exp(lg[:, :, None] * jnp.where(causal, diff, 0.0)[None]), 0.0)
    q_dec = jnp.exp(lg * (idx + 1.0))[None, :, :, None]
    k_dec = jnp.exp(lg * (chunk - 1.0 - idx))[None, :, :, None]
    g_chunk = jnp.exp(log_gamma * chunk)[None, :, None, None]

    def step(s, inp):
        qi, ki, vi = inp
        att = jnp.einsum('bhid,bhjd->bhij', qi, ki) * decay_mat[None]
        o = jnp.einsum('bhij,bhjv->bhiv', att, vi) + jnp.einsum('bhid,bhdv->bhiv', qi * q_dec, s)
        s = s * g_chunk + jnp.einsum('bhjd,bhjv->bhdv', ki * k_dec, vi)
        return s, o

    s, o = lax.scan(step, s0, (to_chunks(q, chunk), to_chunks(k, chunk), to_chunks(v, chunk)))
    return from_chunks(o), s


def gla_chunked(q, k, v, g, s0, chunk):
    causal = jnp.tril(jnp.ones((chunk, chunk), dtype=bool))[None, None, :, :, None]

    def step(s, inp):
        qi, ki, vi, gi = inp
        b = jnp.cumsum(gi, axis=2)
        rel = jnp.where(causal, b[:, :, :, None, :] - b[:, :, None, :, :], -jnp.inf)
        att = jnp.einsum('bhid,bhjd,bhijd->bhij', qi, ki, jnp.exp(rel))
        o = jnp.einsum('bhij,bhjv->bhiv', att, vi) + jnp.einsum('bhid,bhdv->bhiv', qi * jnp.exp(b), s)
        b_last = b[:, :, -1:, :]
        s = s * jnp.exp(b_last[:, :, 0, :])[..., None] + jnp.einsum('bhjd,bhjv->bhdv', ki * jnp.exp(b_last - b), vi)
        return s, o

    s, o = lax.scan(step, s0, (to_chunks(q, chunk), to_chunks(k, chunk), to_chunks(v, chunk), to_chunks(g, chunk)))
    return from_chunks(o), s


def split_heads(a, n_heads):
    B, L, W = a.shape
    return a.reshape(B, L, n_heads, W // n_heads).transpose(0, 2, 1, 3).astype(jnp.float32)


def head_norm(o, gain):
    B, H, L, d = o.shape
    o = o.transpose(0, 2, 1, 3)
    o = o * lax.rsqrt(jnp.mean(o * o, axis=-1, keepdims=True) + EPS)
    return (o * gain.reshape(H, d).astype(jnp.float32)).reshape(B, L, H * d)


def hybrid_layer(x, c, s_ret, s_gla, pos, ret_chunk, gla_chunk,
                 w_ada, b_ada, mix_norm, w_in, w_gk_up, b_gk_up, ret_norm, gla_norm,
                 w_out, ffn_norm, w_gate_up, w_down):
    dt = x.dtype
    mod = jax.nn.silu(c) @ w_ada + b_ada
    sh1, sc1, gt1, sh2, sc2, gt2 = jnp.split(mod[:, None, :], 6, axis=-1)

    h = rmsnorm(x, mix_norm) * (1.0 + sc1) + sh1
    proj = h @ w_in
    cuts = [int(v) for v in np.cumsum(IN_SPLITS)[:-1]]
    q_r, k_r, v_r, g_r, q_g, k_g, v_g, g_g, lr = jnp.split(proj, cuts, axis=-1)

    q_r = rotary(split_heads(q_r, RET_HEADS), pos)
    k_r = rotary(split_heads(k_r, RET_HEADS), pos) * (RET_QK_DIM ** -0.5)
    log_gamma = jnp.log1p(-jnp.exp2(-5.0 - jnp.arange(RET_HEADS, dtype=jnp.float32)))
    o_r, s_ret_new = retention_chunked(q_r, k_r, split_heads(v_r, RET_HEADS),
                                       s_ret.astype(jnp.float32), log_gamma, ret_chunk)
    o_r = head_norm(o_r, ret_norm) * jax.nn.silu(g_r.astype(jnp.float32))

    gk = jax.nn.log_sigmoid((lr @ w_gk_up + b_gk_up).astype(jnp.float32)) / GLA_GATE_NORMALIZER
    q_g = split_heads(q_g, GLA_HEADS) * (GLA_QK_DIM ** -0.5)
    o_g, s_gla_new = gla_chunked(q_g, split_heads(k_g, GLA_HEADS), split_heads(v_g, GLA_HEADS),
                                 split_heads(gk, GLA_HEADS), s_gla.astype(jnp.float32), gla_chunk)
    o_g = head_norm(o_g, gla_norm) * jax.nn.silu(g_g.astype(jnp.float32))

    mix = jnp.concatenate([o_r, o_g], axis=-1).astype(dt) @ w_out
    x = x + gt1 * mix

    h2 = rmsnorm(x, ffn_norm) * (1.0 + sc2) + sh2
    a, b = jnp.split(h2 @ w_gate_up, 2, axis=-1)
    x = x + gt2 * ((jax.nn.silu(a) * b) @ w_down)
    return x, s_ret_new, s_gla_new


def setup_inputs(seed: int = 0) -> dict:
    key = jax.random.key(seed)
    ks = jax.random.split(key, 20)
    f32 = jnp.float32
    n = lambda k, shape, s: jax.random.normal(k, shape, f32) * s
    return {
        "x_prompt": n(ks[0], (BATCH, SEQ, D_MODEL), 1.0),
        "x_sample": n(ks[1], (DEC_BATCH, DEC_SEQ, D_MODEL), 1.0),
        "state_ret": n(ks[2], (DEPTH, DEC_BATCH, RET_HEADS, RET_QK_DIM, RET_V_DIM), 0.1),
        "state_gla": n(ks[3], (DEPTH, DEC_BATCH, GLA_HEADS, GLA_QK_DIM, GLA_V_DIM), 0.1),
        "c_prompt": n(ks[4], (BATCH, D_MODEL), 1.0),
        "c_sample": n(ks[5], (DEC_BATCH, D_MODEL), 1.0),
        "w_ada": n(ks[6], (DEPTH, D_MODEL, 6 * D_MODEL), 0.5 * D_MODEL ** -0.5),
        "b_ada": n(ks[7], (DEPTH, 6 * D_MODEL), 0.01),
        "mix_norm": 1.0 + n(ks[8], (DEPTH, D_MODEL), 0.02),
        "w_in": n(ks[9], (DEPTH, D_MODEL, IN_DIM), D_MODEL ** -0.5),
        "w_gk_up": n(ks[10], (DEPTH, GLA_GATE_RANK, GLA_HEADS * GLA_QK_DIM), GLA_GATE_RANK ** -0.5),
        "b_gk_up": n(ks[11], (DEPTH, GLA_HEADS * GLA_QK_DIM), 0.01),
        "ret_norm": 1.0 + n(ks[12], (DEPTH, RET_WIDTH), 0.02),
        "gla_norm": 1.0 + n(ks[13], (DEPTH, GLA_WIDTH), 0.02),
        "w_out": n(ks[14], (DEPTH, MIX_WIDTH, D_MODEL), MIX_WIDTH ** -0.5),
        "ffn_norm": 1.0 + n(ks[15], (DEPTH, D_MODEL), 0.02),
        "w_gate_up": n(ks[16], (DEPTH, D_MODEL, 2 * D_FF), D_MODEL ** -0.5),
        "w_down": n(ks[17], (DEPTH, D_FF, D_MODEL), D_FF ** -0.5),
        "final_norm": 1.0 + n(ks[18], (D_MODEL,), 0.02),
    }


def reference(x_prompt, x_sample, state_ret, state_gla, c_prompt, c_sample,
              w_ada, b_ada, mix_norm, w_in, w_gk_up, b_gk_up, ret_norm, gla_norm,
              w_out, ffn_norm, w_gate_up, w_down, final_norm):
    pos_prompt = jnp.arange(SEQ, dtype=jnp.int32)
    pos_sample = PAST_LEN + jnp.arange(DEC_SEQ, dtype=jnp.int32)
    L_p = x_prompt.shape[1]
    L_s = x_sample.shape[1]
    ret_chunk_p = min(RET_CHUNK, L_p)
    gla_chunk_p = min(GLA_CHUNK, L_p)
    zero_ret = jnp.zeros((x_prompt.shape[0], RET_HEADS, RET_QK_DIM, RET_V_DIM), jnp.float32)
    zero_gla = jnp.zeros((x_prompt.shape[0], GLA_HEADS, GLA_QK_DIM, GLA_V_DIM), jnp.float32)

    hp, hs = x_prompt, x_sample
    ret_p, gla_p, ret_s, gla_s = [], [], [], []
    for l in range(DEPTH):
        params = (w_ada[l], b_ada[l], mix_norm[l], w_in[l], w_gk_up[l], b_gk_up[l], ret_norm[l],
                  gla_norm[l], w_out[l], ffn_norm[l], w_gate_up[l], w_down[l])
        hp, sr, sg = hybrid_layer(hp, c_prompt, zero_ret, zero_gla, pos_prompt,
                                  ret_chunk_p, gla_chunk_p, *params)
        ret_p.append(sr)
        gla_p.append(sg)
        hs, sr, sg = hybrid_layer(hs, c_sample, state_ret[l], state_gla[l], pos_sample,
                                  L_s, L_s, *params)
        ret_s.append(sr)
        gla_s.append(sg)

    y_prompt = rmsnorm(hp, final_norm)
    y_sample = rmsnorm(hs, final_norm)
    state_ret_prompt = jnp.stack(ret_p)
    state_gla_prompt = jnp.stack(gla_p)
    state_ret_sample = jnp.stack(ret_s)
    state_gla_sample = jnp.stack(gla_s)
    return (y_prompt, y_sample, state_ret_prompt, state_gla_prompt, state_ret_sample, state_gla_sample)
```

```cpp
#include <hip/hip_runtime.h>
#include <hip/hip_cooperative_groups.h>
#include <cstdio>
#include <cstdint>
namespace cg = cooperative_groups;

constexpr int NTOKP = 16384, NTOK = 17408, DM = 1024, NPROJ = 3840, DFF = 2816, MODW = 6144;
__device__ __forceinline__ int row_seq(int row) { return row < NTOKP ? (row >> 11) : 8 + ((row - NTOKP) >> 3); }
__device__ __forceinline__ int row_rope(int row) { return row < NTOKP ? (row & 2047) : 2048 + ((row - NTOKP) & 7); }
namespace pg8 {
#define PG8_LAS __attribute__((address_space(3)))
typedef unsigned short bf16_t;
typedef short bf16x8 __attribute__((ext_vector_type(8)));
typedef float f32x4 __attribute__((ext_vector_type(4)));
typedef unsigned u32x4 __attribute__((ext_vector_type(4)));
constexpr int BM = 256, BK = 64, HALF = 128, HTB = HALF * BK * 2  , STAGE_BYTES = 8 * HTB, NXCD = 8, WGM = 8;

__host__ __device__ __forceinline__ int lds_byte(int r, int c) { const int st = (r >> 4) * 2 + (c >> 5), rr = r & 15, cc = c & 31, ob = rr * 64 + cc * 2; return st * 1024 + (ob ^ (((ob >> 9) & 1) << 5)); }
__host__ __device__ __forceinline__ void stage_rc(int b, int& R, int& C) { const int st = b / 1024, sb = b % 1024, swz = sb ^ (((sb >> 9) & 1) << 5); R = (st >> 1) * 16 + swz / 64; C = (st & 1) * 32 + (swz % 64) / 2; }
__host__ __device__ __forceinline__ int perm32(int rho) { const int n = rho >> 4, i = rho & 15; return 8 * (i >> 2) + 4 * n + (i & 3); }

struct Unit { int pm, pn; };
struct Gemm { const bf16_t* A; const bf16_t* Bt; int M, N, K; };

struct StaticOrder {
    int nM, nN, nwg, G, c;
    __host__ __device__ void init(int M, int N, int G_, int c_) { nM = M / BM; nN = N / BM; nwg = nM * nN; G = G_; c = c_; }
    __host__ __device__ bool next(int i, Unit& u) const {
        const long L = (long)i * G + c; if (L >= nwg) return false;
        int wgid = (int)L; { const int q = nwg / NXCD, r = nwg % NXCD, xcd = wgid % NXCD, off = wgid / NXCD; wgid = (xcd < r ? xcd * (q + 1) : r * (q + 1) + (xcd - r) * q) + off; }
        const int nig = WGM * nN, gid = wgid / nig, fm = gid * WGM, gsz = (nM - fm) < WGM ? (nM - fm) : WGM;
        u.pm = fm + ((wgid % nig) % gsz); u.pn = (wgid % nig) / gsz; return true;
    }
    __device__ __forceinline__ void a_ready(const Unit&) const {}
    __device__ __forceinline__ void done(const Unit&) const {}
};

__device__ __forceinline__ unsigned cvt_pk_bf16(float lo, float hi) { unsigned r; asm volatile("v_cvt_pk_bf16_f32 %0, %1, %2" : "=v"(r) : "v"(lo), "v"(hi)); return r; }
struct EpiProj {
    static constexpr bool PERM = true, AFTER_DRAIN = false;
    bf16_t* O; const float* cs; const float* sn;
    __device__ __forceinline__ void operator()(const f32x4 (&acc)[2][2][4][2], const Unit& u, int wr, int wc, int fr, int fq) const {
        const int row0 = u.pm * BM + wr * 64 + fr;
        if (u.pn < 4) {
            const int hl = wc >> 1, f0 = 32 * (wc & 1) + 8 * fq;
            const float scale = (u.pn >= 2) ? 0.08838834764831845f : 1.0f;
            const int colbase = u.pn * 256 + hl * 128 + f0;
#pragma unroll
            for (int ai = 0; ai < 2; ++ai)
#pragma unroll
                for (int m = 0; m < 4; ++m) {
                    const int row = row0 + ai * HALF + m * 16; const int pr = row_rope(row);
                    const f32x4 c0 = *(const f32x4*)(cs + pr * 64 + f0), c1 = *(const f32x4*)(cs + pr * 64 + f0 + 4);
                    const f32x4 s0 = *(const f32x4*)(sn + pr * 64 + f0), s1 = *(const f32x4*)(sn + pr * 64 + f0 + 4);
                    const f32x4 x10 = acc[ai][0][m][0], x11 = acc[ai][0][m][1], x20 = acc[ai][1][m][0], x21 = acc[ai][1][m][1];
                    const f32x4 a0 = (x10 * c0 - x20 * s0) * scale, a1 = (x11 * c1 - x21 * s1) * scale;
                    const f32x4 b0 = (x10 * s0 + x20 * c0) * scale, b1 = (x11 * s1 + x21 * c1) * scale;
                    bf16_t* rowp = O + (size_t)row * NPROJ + colbase;
                    u32x4 w; w.x = cvt_pk_bf16(a0[0], a0[1]); w.y = cvt_pk_bf16(a0[2], a0[3]); w.z = cvt_pk_bf16(a1[0], a1[1]); w.w = cvt_pk_bf16(a1[2], a1[3]);
                    *(u32x4*)rowp = w;
                    w.x = cvt_pk_bf16(b0[0], b0[1]); w.y = cvt_pk_bf16(b0[2], b0[3]); w.z = cvt_pk_bf16(b1[0], b1[1]); w.w = cvt_pk_bf16(b1[2], b1[3]);
                    *(u32x4*)(rowp + 64) = w;
                }
        } else {
            const float sc = (u.pn == 8) ? 0.125f : 1.0f;
            const int col0 = u.pn * BM + wc * 32 + 8 * fq;
#pragma unroll
            for (int ai = 0; ai < 2; ++ai)
#pragma unroll
                for (int m = 0; m < 4; ++m) { bf16_t* rowp = O + (size_t)(row0 + ai * HALF + m * 16) * NPROJ + col0;
#pragma unroll
                    for (int bj = 0; bj < 2; ++bj) { const f32x4 v0 = acc[ai][bj][m][0] * sc, v1 = acc[ai][bj][m][1] * sc;
                        u32x4 w; w.x = cvt_pk_bf16(v0[0], v0[1]); w.y = cvt_pk_bf16(v0[2], v0[3]); w.z = cvt_pk_bf16(v1[0], v1[1]); w.w = cvt_pk_bf16(v1[2], v1[3]);
                        *(u32x4*)(rowp + bj * HALF) = w; } }
        }
    }
};
struct EpiRes {
    static constexpr bool PERM = false, AFTER_DRAIN = false;
    const float* base_p; const float* base_s; float* out; const float* gate;
    __device__ __forceinline__ void operator()(const f32x4 (&acc)[2][2][4][2], const Unit& u, int wr, int wc, int fr, int fq) const {
        const int row0 = u.pm * BM + wr * 64 + fr, col0 = u.pn * BM + wc * 32 + 4 * fq;
#pragma unroll
        for (int ai = 0; ai < 2; ++ai)
#pragma unroll
            for (int m = 0; m < 4; ++m) {
                const int row = row0 + ai * HALF + m * 16;
                const float* brow = row < NTOKP ? base_p + (size_t)row * DM : base_s + (size_t)(row - NTOKP) * DM;
                const float* g = gate + (size_t)row_seq(row) * MODW;
                float* orow = out + (size_t)row * DM;
#pragma unroll
                for (int bj = 0; bj < 2; ++bj)
#pragma unroll
                    for (int n = 0; n < 2; ++n) { const int c = col0 + bj * HALF + n * 16;
                        const f32x4 bv = *(const f32x4*)(brow + c), gv = *(const f32x4*)(g + c);
                        *(f32x4*)(orow + c) = bv + gv * acc[ai][bj][m][n]; }
            }
    }
};
struct EpiSwiGLU {
    static constexpr bool PERM = true, AFTER_DRAIN = false;
    bf16_t* O;
    __device__ __forceinline__ void operator()(const f32x4 (&acc)[2][2][4][2], const Unit& u, int wr, int wc, int fr, int fq) const {
        const int row0 = u.pm * BM + wr * 64 + fr, col0 = u.pn * HALF + wc * 32 + 8 * fq;
#pragma unroll
        for (int ai = 0; ai < 2; ++ai)
#pragma unroll
            for (int m = 0; m < 4; ++m) {
                float v[8];
#pragma unroll
                for (int n = 0; n < 2; ++n)
#pragma unroll
                    for (int e = 0; e < 4; ++e) { const float a = acc[ai][0][m][n][e], b = acc[ai][1][m][n][e];
                        v[n * 4 + e] = a * __builtin_amdgcn_rcpf(1.0f + __expf(-a)) * b; }
                u32x4 w; w.x = cvt_pk_bf16(v[0], v[1]); w.y = cvt_pk_bf16(v[2], v[3]); w.z = cvt_pk_bf16(v[4], v[5]); w.w = cvt_pk_bf16(v[6], v[7]);
                *(u32x4*)(O + (size_t)(row0 + ai * HALF + m * 16) * DFF + col0) = w;
            }
    }
};

template <class Epi, class Sched, bool ALIGN_EPI = false, bool SP2 = false>
__device__ __forceinline__ void gemm_phase(PG8_LAS unsigned char* lds, const Gemm g, const Sched& S, const Epi& E) {
    const int tid = threadIdx.x, wid = __builtin_amdgcn_readfirstlane(tid >> 6), lane = tid & 63, wr = wid >> 2, wc = wid & 3, fr = lane & 15, fq = lane >> 4;
    const int K = g.K, nt = K / BK;
    unsigned voffA[2], voffB[2];
#pragma unroll
    for (int i = 0; i < 2; ++i) { int R, C; stage_rc(tid * 16 + i * 8192, R, C); const int Rb = Epi::PERM ? ((R & ~31) + perm32(R & 31)) : R;
        voffA[i] = (unsigned)(R * K + C) * 2u; voffB[i] = (unsigned)(Rb * K + C) * 2u; }
    const size_t kstep = (size_t)(BK * 2);
    const size_t hstep = (size_t)HALF * K * 2;
    const size_t tstep = 2 * hstep;
    const unsigned ldsw = (unsigned)wid * 1024u;
    const int aoff = lds_byte(wr * 64 + fr, fq * 8), boff = lds_byte(wc * 32 + fr, fq * 8);
#define PG8_SA(b, h) (((b) * 2 + (h)) * HTB)
#define PG8_SB(b, h) ((4 + (b) * 2 + (h)) * HTB)
#define PG8_STAGE(bufoff, gbase, voff) do { _Pragma("unroll") for (int _i = 0; _i < 2; ++_i) \
        __builtin_amdgcn_global_load_lds((const unsigned*)((const char*)(gbase) + (voff)[_i]), (PG8_LAS unsigned*)(lds + (bufoff) + ldsw + _i * 8192), 16, 0, 0); } while (0)
#define PG8_LDA(dst, b, h) do { _Pragma("unroll") for (int m = 0; m < 4; ++m) _Pragma("unroll") for (int k = 0; k < 2; ++k) dst[m][k] = *(const PG8_LAS bf16x8*)(lds + PG8_SA(b, h) + aoff + m * 2048 + k * 1024); } while (0)
#define PG8_LDB(dst, b, h) do { _Pragma("unroll") for (int n = 0; n < 2; ++n) _Pragma("unroll") for (int k = 0; k < 2; ++k) dst[n][k] = *(const PG8_LAS bf16x8*)(lds + PG8_SB(b, h) + boff + n * 2048 + k * 1024); } while (0)
#define PG8_MMA(ai, bj, At, Bt) do { __builtin_amdgcn_s_setprio(1); _Pragma("unroll") for (int m = 0; m < 4; ++m) _Pragma("unroll") for (int n = 0; n < 2; ++n) _Pragma("unroll") for (int k = 0; k < 2; ++k) \
        acc[ai][bj][m][n] = __builtin_amdgcn_mfma_f32_16x16x32_bf16(Bt[n][k], At[m][k], acc[ai][bj][m][n], 0, 0, 0); __builtin_amdgcn_s_setprio(0); } while (0)
#define PG8_WAIT_V(n) asm volatile("s_waitcnt vmcnt(" #n ")" ::: "memory")
#define PG8_WAIT_L(n) asm volatile("s_waitcnt lgkmcnt(" #n ")" ::: "memory")
#define PG8_BAR __builtin_amdgcn_s_barrier()
#define PG8_SCHED __builtin_amdgcn_sched_barrier(0)
    Unit cur, nxt; int ui = 0;
    if (!S.next(0, cur)) return;
    f32x4 acc[2][2][4][2];
#pragma unroll
    for (int a = 0; a < 2; ++a)
#pragma unroll
        for (int b = 0; b < 2; ++b)
#pragma unroll
            for (int m = 0; m < 4; ++m)
#pragma unroll
                for (int n = 0; n < 2; ++n) acc[a][b][m][n] = (f32x4){0.f, 0.f, 0.f, 0.f};
    bf16x8 At[4][2], B0[2][2], B1[2][2];
    const char* cA = (const char*)g.A + (size_t)cur.pm * tstep; const char* cB = (const char*)g.Bt + (size_t)cur.pn * tstep;
    S.a_ready(cur);
    if constexpr (SP2) {
        PG8_STAGE(PG8_SB(0, 0), cB, voffB); PG8_STAGE(PG8_SB(0, 1), cB + hstep, voffB); PG8_STAGE(PG8_SA(0, 0), cA, voffA); PG8_STAGE(PG8_SA(0, 1), cA + hstep, voffA);
        if (wr == 1) PG8_BAR;
        PG8_WAIT_V(2); PG8_BAR;
        PG8_STAGE(PG8_SB(1, 0), cB + kstep, voffB); PG8_STAGE(PG8_SA(1, 0), cA + kstep, voffA); PG8_STAGE(PG8_SB(1, 1), cB + hstep + kstep, voffB);
        PG8_WAIT_V(6); PG8_BAR;
    } else {
        PG8_STAGE(PG8_SB(0, 0), cB, voffB); PG8_STAGE(PG8_SA(0, 0), cA, voffA); PG8_STAGE(PG8_SB(0, 1), cB + hstep, voffB); PG8_STAGE(PG8_SA(0, 1), cA + hstep, voffA);
        if (wr == 1) PG8_BAR;
        PG8_WAIT_V(4); PG8_BAR;
        PG8_STAGE(PG8_SB(1, 0), cB + kstep, voffB); PG8_STAGE(PG8_SA(1, 0), cA + kstep, voffA); PG8_STAGE(PG8_SB(1, 1), cB + hstep + kstep, voffB);
        PG8_WAIT_V(6); PG8_BAR;
    }
    for (;;) {
        const bool has_next = S.next(ui + 1, nxt);
        const char* nA = has_next ? (const char*)g.A + (size_t)nxt.pm * tstep : cA; const char* nB = has_next ? (const char*)g.Bt + (size_t)nxt.pn * tstep : cB;
        for (int t = 0; t < nt; t += 2) {
            const bool last = (t == nt - 2);
            const char* a1 = cA + (size_t)(t + 1) * kstep;
            const char* a2 = last ? nA : cA + (size_t)(t + 2) * kstep; const char* b2 = last ? nB : cB + (size_t)(t + 2) * kstep;
            const char* a3 = a2 + kstep; const char* b3 = b2 + kstep;
            if (last && has_next) S.a_ready(nxt);
            if constexpr (SP2) {
            PG8_LDB(B0, 0, 0); PG8_LDB(B1, 0, 1); PG8_SCHED; PG8_LDA(At, 0, 0); PG8_STAGE(PG8_SA(1, 1), a1 + hstep, voffA);
            PG8_WAIT_V(8); PG8_WAIT_L(0); PG8_BAR; PG8_MMA(0, 0, At, B0); PG8_MMA(0, 1, At, B1); PG8_BAR; PG8_SCHED;
            PG8_LDA(At, 0, 1); PG8_STAGE(PG8_SB(0, 0), b2, voffB); PG8_STAGE(PG8_SB(0, 1), b2 + hstep, voffB); PG8_STAGE(PG8_SA(0, 0), a2, voffA);
            PG8_WAIT_V(8); PG8_WAIT_L(0); PG8_BAR; PG8_MMA(1, 0, At, B0); PG8_MMA(1, 1, At, B1); PG8_BAR; PG8_SCHED;
            PG8_LDB(B0, 1, 0); PG8_LDB(B1, 1, 1); PG8_SCHED; PG8_LDA(At, 1, 0); PG8_STAGE(PG8_SA(0, 1), a2 + hstep, voffA);
            PG8_WAIT_V(8); PG8_WAIT_L(0); PG8_BAR; PG8_MMA(0, 0, At, B0); PG8_MMA(0, 1, At, B1); PG8_BAR; PG8_SCHED;
            PG8_LDA(At, 1, 1); PG8_STAGE(PG8_SB(1, 0), b3, voffB); PG8_STAGE(PG8_SB(1, 1), b3 + hstep, voffB); PG8_STAGE(PG8_SA(1, 0), a3, voffA);
            PG8_WAIT_V(8); PG8_WAIT_L(0); PG8_BAR; PG8_MMA(1, 0, At, B0); PG8_MMA(1, 1, At, B1); PG8_BAR; PG8_SCHED;
            } else {
            PG8_LDB(B0, 0, 0); PG8_SCHED; PG8_LDA(At, 0, 0); PG8_STAGE(PG8_SA(1, 1), a1 + hstep, voffA);
            PG8_WAIT_L(8); PG8_BAR; PG8_WAIT_L(0); PG8_MMA(0, 0, At, B0); PG8_BAR; PG8_SCHED;
            PG8_LDB(B1, 0, 1); PG8_STAGE(PG8_SB(0, 0), b2, voffB);
            PG8_BAR; PG8_WAIT_L(0); PG8_MMA(0, 1, At, B1); PG8_BAR;
            PG8_LDA(At, 0, 1); PG8_STAGE(PG8_SA(0, 0), a2, voffA);
            PG8_BAR; PG8_WAIT_L(0); PG8_MMA(1, 0, At, B0); PG8_BAR; PG8_SCHED;
            PG8_STAGE(PG8_SB(0, 1), b2 + hstep, voffB);
            PG8_WAIT_V(6); PG8_BAR; PG8_MMA(1, 1, At, B1); PG8_BAR;
            PG8_LDB(B0, 1, 0); PG8_SCHED; PG8_LDA(At, 1, 0); PG8_STAGE(PG8_SA(0, 1), a2 + hstep, voffA);
            PG8_WAIT_L(8); PG8_BAR; PG8_WAIT_L(0); PG8_MMA(0, 0, At, B0); PG8_BAR; PG8_SCHED;
            PG8_LDB(B1, 1, 1); PG8_STAGE(PG8_SB(1, 0), b3, voffB);
            PG8_BAR; PG8_WAIT_L(0); PG8_MMA(0, 1, At, B1); PG8_BAR;
            PG8_LDA(At, 1, 1); PG8_STAGE(PG8_SA(1, 0), a3, voffA);
            PG8_BAR; PG8_WAIT_L(0); PG8_MMA(1, 0, At, B0); PG8_BAR; PG8_SCHED;
            PG8_STAGE(PG8_SB(1, 1), b3 + hstep, voffB);
            PG8_WAIT_V(6); PG8_BAR; PG8_MMA(1, 1, At, B1); PG8_BAR;
            }
        }
        if constexpr (ALIGN_EPI) { if (wr == 0) PG8_BAR; }
        if constexpr (!Epi::AFTER_DRAIN) { E(acc, cur, wr, wc, fr, fq); S.done(cur); }
        if (!has_next) break;
#pragma unroll
        for (int a = 0; a < 2; ++a)
#pragma unroll
            for (int b = 0; b < 2; ++b)
#pragma unroll
                for (int m = 0; m < 4; ++m)
#pragma unroll
                    for (int n = 0; n < 2; ++n) acc[a][b][m][n] = (f32x4){0.f, 0.f, 0.f, 0.f};
        cur = nxt; cA = nA; cB = nB; ++ui;
        if constexpr (ALIGN_EPI) { if (wr == 1) PG8_BAR; }
    }
    PG8_WAIT_V(0);
    if constexpr (!ALIGN_EPI) { if (wr == 0) PG8_BAR; }
    PG8_BAR;
    if constexpr (Epi::AFTER_DRAIN) { E.fused(acc, cur, wr, wc, fr, fq, lds, wid, lane); S.done(cur); }
#undef PG8_SA
#undef PG8_SB
#undef PG8_STAGE
#undef PG8_LDA
#undef PG8_LDB
#undef PG8_MMA
#undef PG8_WAIT_V
#undef PG8_WAIT_L
#undef PG8_BAR
#undef PG8_SCHED
}
}
#define LAS __attribute__((address_space(3)))
typedef unsigned short bf16;
typedef unsigned v4u __attribute__((ext_vector_type(4)));
typedef unsigned v2u __attribute__((ext_vector_type(2)));
typedef float f32x4 __attribute__((ext_vector_type(4)));
typedef short bf16x8 __attribute__((ext_vector_type(8)));
constexpr int NTHR = 512;
constexpr int LDS_BYTES = 147456;
constexpr size_t MiB = 1u << 20;
constexpr size_t WS_WIN = 1 * MiB, WS_WOUT = 9 * MiB, WS_WGU = 11 * MiB, WS_WDN = 22 * MiB, WS_MOD = 28 * MiB, WS_ROPE = 32 * MiB;
constexpr size_t WS_H = 34 * MiB, WS_MIX = 68 * MiB, WS_PROJ = 102 * MiB, WS_END = 230 * MiB;
constexpr size_t WS_SRET = WS_H, WS_SGLA = WS_H + 16 * MiB, WS_HID = WS_PROJ;
constexpr int ROPE_ROWS = 2056;
constexpr int C_QR = 0, C_KR = 512, C_VR = 1024, C_GR = 1536, C_QG = 2048, C_KG = 2304, C_VG = 2560, C_GG = 3072, C_LR = 3584;
constexpr size_t O_Y = 0, O_SRP = (size_t)NTOK * DM, O_SGP = O_SRP + 8 * 4 * 128 * 128, O_SRS = O_SGP + 8 * 4 * 64 * 128, O_SGS = O_SRS + (size_t)128 * 4 * 128 * 128;

__device__ __forceinline__ float bf2f(unsigned h) { return __uint_as_float(h << 16); }
__device__ __forceinline__ unsigned pk2(float lo, float hi) { return pg8::cvt_pk_bf16(lo, hi); }
__device__ __forceinline__ bf16 f2bf(float f) { unsigned u = __float_as_uint(f); return (bf16)((u + 0x7fffu + ((u >> 16) & 1u)) >> 16); }
__device__ __forceinline__ float wave_sum(float v) {
#pragma unroll
    for (int o = 32; o >= 1; o >>= 1) v += __shfl_xor(v, o);
    return v;
}
__device__ __forceinline__ float silu_f(float a) { return a * __builtin_amdgcn_rcpf(1.0f + __expf(-a)); }
__device__ __forceinline__ float logsig16(float z) { return (fminf(z, 0.f) - __logf(1.0f + __expf(-fabsf(z)))) * 0.0625f; }
__device__ __forceinline__ bf16x8 frag(const LAS bf16* base, int row, int kofs, int ls) { return *(const LAS bf16x8*)(base + row * ls + kofs); }
#define MFMA16(a, b, c) __builtin_amdgcn_mfma_f32_16x16x32_bf16((a), (b), (c), 0, 0, 0)

template <int R, int C8> __device__ __forceinline__ void tile_g2l(const bf16* g, size_t gp, LAS bf16* l, int ls) {
    for (int idx = threadIdx.x; idx < R * C8; idx += NTHR) { const int r = idx / C8, c = idx % C8;
        const v4u v = *(const v4u*)(g + (size_t)r * gp + c * 8); *(LAS v4u*)(l + r * ls + c * 8) = v; }
}
template <int J, int V8> __device__ __forceinline__ void tile_g2l_T(const bf16* g, size_t gp, LAS bf16* l, int ls) {
    for (int idx = threadIdx.x; idx < V8 * (J / 2); idx += NTHR) { const int v8 = idx / (J / 2), jp = idx % (J / 2);
        const v4u a = *(const v4u*)(g + (size_t)(2 * jp) * gp + v8 * 8), b = *(const v4u*)(g + (size_t)(2 * jp + 1) * gp + v8 * 8);
#pragma unroll
        for (int e = 0; e < 4; ++e) {
            *(LAS unsigned*)(l + (v8 * 8 + 2 * e) * ls + 2 * jp) = (a[e] & 0xffffu) | (b[e] << 16);
            *(LAS unsigned*)(l + (v8 * 8 + 2 * e + 1) * ls + 2 * jp) = (a[e] >> 16) | (b[e] & 0xffff0000u);
        }
    }
}

struct Frame {
    const float *x_p, *x_s, *st_ret, *st_gla, *c_p, *c_s, *w_ada, *b_ada, *mix_norm, *w_in, *w_gk, *b_gk, *ret_norm, *gla_norm, *w_out, *ffn_norm, *w_gu, *w_dn, *fin_norm;
    float* out; unsigned char* ws;
    bf16 *WIN, *WOUT, *WGU, *WDN, *H, *MIX, *PROJ, *HID, *SRET, *SGLA; float *MOD, *RC, *RS;
};

__device__ __forceinline__ void p0_transpose_item(const float* W, int ldw, bf16* WT, int K, int kind, int item, LAS float* scr) {
    const int t = threadIdx.x, nkt = K / 64, nt = item / nkt, kt = item % nkt, r0 = nt * 64;
    int src0 = r0, valid = 64;
    if (kind == 0) { if (r0 < 1024) { const int pn = r0 >> 8, within = r0 & 255, bj = within >> 7, hl = (within & 127) >> 6; src0 = pn * 256 + hl * 128 + bj * 64; }
                     else { valid = 3600 - r0; valid = valid < 0 ? 0 : (valid > 64 ? 64 : valid); } }
    else if (kind == 1) { const int pn = r0 >> 8, within = r0 & 255, bj = within >> 7, idx = within & 127; src0 = bj * DFF + pn * 128 + idx; }
#pragma unroll
    for (int i = 0; i < 2; ++i) { const int kk = (t >> 4) + 32 * i, c4 = (t & 15) * 4;
        f32x4 v = (f32x4){0.f, 0.f, 0.f, 0.f};
        if (c4 < valid) v = *(const f32x4*)(W + (size_t)(kt * 64 + kk) * ldw + src0 + c4);
        scr[kk * 65 + c4] = v[0]; scr[kk * 65 + c4 + 1] = v[1]; scr[kk * 65 + c4 + 2] = v[2]; scr[kk * 65 + c4 + 3] = v[3]; }
    __syncthreads();
    { const int n = t >> 3, k8 = (t & 7) * 8; v4u w;
      w.x = pk2(scr[(k8 + 0) * 65 + n], scr[(k8 + 1) * 65 + n]); w.y = pk2(scr[(k8 + 2) * 65 + n], scr[(k8 + 3) * 65 + n]);
      w.z = pk2(scr[(k8 + 4) * 65 + n], scr[(k8 + 5) * 65 + n]); w.w = pk2(scr[(k8 + 6) * 65 + n], scr[(k8 + 7) * 65 + n]);
      *(v4u*)(WT + (size_t)(r0 + n) * K + kt * 64 + k8) = w; }
    __syncthreads();
}
__device__ __forceinline__ void p0_mod_slab(const Frame& F, int slab, LAS float* sc, LAS float* wl) {
    const int t = threadIdx.x, col = t & 31, rg = t >> 5;
    float acc[9];
#pragma unroll
    for (int i = 0; i < 9; ++i) acc[i] = 0.f;
    for (int k0 = 0; k0 < DM; k0 += 64) {
        for (int idx = t; idx < 136 * 64; idx += NTHR) { const int r = idx >> 6, k = idx & 63;
            const float c = r < 8 ? F.c_p[r * DM + k0 + k] : F.c_s[(r - 8) * DM + k0 + k]; sc[r * 68 + k] = silu_f(c); }
        { const int k = t >> 3, c4 = (t & 7) * 4; const f32x4 v = *(const f32x4*)(F.w_ada + (size_t)(k0 + k) * MODW + slab * 32 + c4); *(LAS f32x4*)(wl + k * 32 + c4) = v; }
        __syncthreads();
        for (int k4 = 0; k4 < 64; k4 += 4) {
            const float w0 = wl[k4 * 32 + col], w1 = wl[(k4 + 1) * 32 + col], w2 = wl[(k4 + 2) * 32 + col], w3 = wl[(k4 + 3) * 32 + col];
#pragma unroll
            for (int i = 0; i < 9; ++i) { const int r = rg + 16 * i; if (r < 136) { const f32x4 s = *(const LAS f32x4*)(sc + r * 68 + k4); acc[i] += s[0] * w0 + s[1] * w1 + s[2] * w2 + s[3] * w3; } }
        }
        __syncthreads();
    }
    const float bb = F.b_ada[slab * 32 + col];
#pragma unroll
    for (int i = 0; i < 9; ++i) { const int r = rg + 16 * i; if (r < 136) F.MOD[(size_t)r * MODW + slab * 32 + col] = acc[i] + bb; }
}
__device__ __forceinline__ void p0_prologue(const Frame& F, LAS unsigned char* lds) {
    const int G = gridDim.x, bx = blockIdx.x;
    LAS float* scr = (LAS float*)lds;
    for (int idx = bx * NTHR + threadIdx.x; idx < ROPE_ROWS * 64; idx += G * NTHR) { const int p = idx >> 6, j = idx & 63; const int pos = p < 2048 ? p : 16384 + (p - 2048);
        const float inv = (float)exp2(-(double)j * (13.287712379549449 / 64.0)); const float ang = (float)pos * inv;
        double rev = (double)ang * 0.15915494309189535; rev -= __builtin_rint(rev); const float fr = (float)rev;
        F.RC[idx] = __builtin_amdgcn_cosf(fr); F.RS[idx] = __builtin_amdgcn_sinf(fr); }
    if (bx >= G - 192 && G >= 192) p0_mod_slab(F, bx - (G - 192), scr, scr + 136 * 68);
    else if (G < 192) for (int s = bx; s < 192; s += G) p0_mod_slab(F, s, scr, scr + 136 * 68);
    constexpr int N_IN = 60 * 16, N_OUT = 16 * 16, N_GU = 88 * 16, N_DN = 16 * 44;
    for (int it = bx; it < N_IN + N_OUT + N_GU + N_DN; it += G) {
        if (it < N_IN) p0_transpose_item(F.w_in, 3600, F.WIN, DM, 0, it, scr);
        else if (it < N_IN + N_OUT) p0_transpose_item(F.w_out, DM, F.WOUT, DM, 2, it - N_IN, scr);
        else if (it < N_IN + N_OUT + N_GU) p0_transpose_item(F.w_gu, 2 * DFF, F.WGU, DM, 1, it - N_IN - N_OUT, scr);
        else p0_transpose_item(F.w_dn, DM, F.WDN, DFF, 2, it - N_IN - N_OUT - N_GU, scr);
    }
}
template <bool MODULATE> __device__ __forceinline__ void norm_phase(const float* xp, const float* xs, const float* gain, const float* mod, int shi, int sci, bf16* H, float* Y) {
    const int lane = threadIdx.x & 63, gw = blockIdx.x * 8 + (threadIdx.x >> 6), nw = gridDim.x * 8;
    f32x4 g[4];
#pragma unroll
    for (int i = 0; i < 4; ++i) g[i] = *(const f32x4*)(gain + 4 * lane + 256 * i);
    for (int row = gw; row < NTOK; row += nw) {
        const float* x = row < NTOKP ? xp + (size_t)row * DM : xs + (size_t)(row - NTOKP) * DM;
        f32x4 v[4]; float ss = 0.f;
#pragma unroll
        for (int i = 0; i < 4; ++i) { v[i] = *(const f32x4*)(x + 4 * lane + 256 * i); ss += v[i][0] * v[i][0] + v[i][1] * v[i][1] + v[i][2] * v[i][2] + v[i][3] * v[i][3]; }
        ss = wave_sum(ss);
        const float rstd = rsqrtf(ss * (1.0f / DM) + 1e-6f);
        if (MODULATE) {
            const float* m = mod + (size_t)row_seq(row) * MODW;
#pragma unroll
            for (int i = 0; i < 4; ++i) { const int c = 4 * lane + 256 * i;
                const f32x4 sc = *(const f32x4*)(m + sci * DM + c), sh = *(const f32x4*)(m + shi * DM + c);
                const f32x4 o = v[i] * rstd * g[i] * (sc + 1.0f) + sh;
                v2u w; w.x = pk2(o[0], o[1]); w.y = pk2(o[2], o[3]); *(v2u*)(H + (size_t)row * DM + c) = w; }
        } else {
#pragma unroll
            for (int i = 0; i < 4; ++i) { const int c = 4 * lane + 256 * i; *(f32x4*)(Y + (size_t)row * DM + c) = v[i] * rstd * g[i]; }
        }
    }
}
__device__ __forceinline__ void ret_pass1(const Frame& F, int item, LAS unsigned char* lds) {
    const int b = item >> 4, h = (item >> 2) & 3, s = item & 3;
    const int t = threadIdx.x, lane = t & 63, w = __builtin_amdgcn_readfirstlane(t >> 6), l15 = lane & 15, quad = lane >> 4;
    LAS bf16* Kt = (LAS bf16*)lds;
    LAS bf16* Vt = Kt + 128 * 136;
    const float lg2 = log1pf(-exp2f(-5.0f - (float)h)) * 1.4426950408889634f;
    const float gC = exp2f(lg2 * 128.0f);
    f32x4 acc[2]; acc[0] = (f32x4){0.f, 0.f, 0.f, 0.f}; acc[1] = acc[0];
    for (int n = 0; n < 16; ++n) {
        const bf16* kg = F.PROJ + (size_t)(b * 2048 + n * 128) * NPROJ + C_KR + h * 128;
        const bf16* vg = F.PROJ + (size_t)(b * 2048 + n * 128) * NPROJ + C_VR + h * 128 + s * 32;
        for (int idx = t; idx < 1024; idx += NTHR) { const int d8 = idx >> 6, jp = idx & 63;
            const v4u a = *(const v4u*)(kg + (size_t)(2 * jp) * NPROJ + d8 * 8), bb = *(const v4u*)(kg + (size_t)(2 * jp + 1) * NPROJ + d8 * 8);
            const float da = __builtin_amdgcn_exp2f(lg2 * (float)(127 - 2 * jp)), db = __builtin_amdgcn_exp2f(lg2 * (float)(126 - 2 * jp));
#pragma unroll
            for (int e = 0; e < 4; ++e) {
                *(LAS unsigned*)(Kt + (d8 * 8 + 2 * e) * 136 + 2 * jp) = pk2(bf2f(a[e] & 0xffffu) * da, bf2f(bb[e] & 0xffffu) * db);
                *(LAS unsigned*)(Kt + (d8 * 8 + 2 * e + 1) * 136 + 2 * jp) = pk2(bf2f(a[e] >> 16) * da, bf2f(bb[e] >> 16) * db);
            } }
        tile_g2l_T<128, 4>(vg, NPROJ, Vt, 136);
        { bf16* sp = F.SRET + (size_t)((b * 4 + h) * 16 + n) * 16384;
#pragma unroll
          for (int vt = 0; vt < 2; ++vt)
#pragma unroll
              for (int r = 0; r < 4; ++r) sp[(s * 32 + 16 * vt + quad * 4 + r) * 128 + 16 * w + l15] = f2bf(acc[vt][r]); }
        __syncthreads();
#pragma unroll
        for (int vt = 0; vt < 2; ++vt) { acc[vt] = acc[vt] * gC;
#pragma unroll
            for (int ks = 0; ks < 4; ++ks) acc[vt] = MFMA16(frag(Vt, 16 * vt + l15, ks * 32 + quad * 8, 136), frag(Kt, 16 * w + l15, ks * 32 + quad * 8, 136), acc[vt]); }
        __syncthreads();
    }
    float* so = F.out + O_SRP + (size_t)(b * 4 + h) * 16384;
#pragma unroll
    for (int vt = 0; vt < 2; ++vt)
#pragma unroll
        for (int r = 0; r < 4; ++r) so[(16 * w + l15) * 128 + s * 32 + 16 * vt + quad * 4 + r] = acc[vt][r];
}
__device__ __forceinline__ void gla_gk_cumsum(const Frame& F, int h, size_t row0, LAS float* bcum, LAS float* lrs, LAS float* tot) {
    const int t = threadIdx.x, dcol = t & 63, jg = t >> 6;
    if (t < 128) { const int j = t >> 1, hf = t & 1; const v4u v = *(const v4u*)(F.PROJ + (row0 + j) * NPROJ + C_LR + hf * 8);
#pragma unroll
        for (int e = 0; e < 4; ++e) { lrs[j * 16 + hf * 8 + 2 * e] = bf2f(v[e] & 0xffffu); lrs[j * 16 + hf * 8 + 2 * e + 1] = bf2f(v[e] >> 16); } }
    float w2[16];
#pragma unroll
    for (int r = 0; r < 16; ++r) w2[r] = F.w_gk[r * 256 + h * 64 + dcol];
    const float bias = F.b_gk[h * 64 + dcol];
    __syncthreads();
    float gl[8]; float run = 0.f;
#pragma unroll
    for (int i = 0; i < 8; ++i) { float z = bias;
#pragma unroll
        for (int r4 = 0; r4 < 4; ++r4) { const f32x4 l = *(const LAS f32x4*)(lrs + (jg * 8 + i) * 16 + r4 * 4); z += l[0] * w2[r4 * 4] + l[1] * w2[r4 * 4 + 1] + l[2] * w2[r4 * 4 + 2] + l[3] * w2[r4 * 4 + 3]; }
        run += logsig16(z); gl[i] = run; }
    tot[jg * 64 + dcol] = run;
    __syncthreads();
    float pre = 0.f;
#pragma unroll
    for (int q = 0; q < 8; ++q) { const float v = tot[q * 64 + dcol]; pre += (q < jg) ? v : 0.f; }
#pragma unroll
    for (int i = 0; i < 8; ++i) bcum[(jg * 8 + i) * 64 + dcol] = pre + gl[i];
    __syncthreads();
}
__device__ __forceinline__ void gla_pass1(const Frame& F, int item, LAS unsigned char* lds) {
    const int b = item >> 4, h = (item >> 2) & 3, s = item & 3;
    const int t = threadIdx.x, lane = t & 63, w = __builtin_amdgcn_readfirstlane(t >> 6), l15 = lane & 15, quad = lane >> 4;
    LAS bf16* Kt = (LAS bf16*)lds;
    LAS bf16* Vt = Kt + 64 * 72;
    LAS float* bcum = (LAS float*)(lds + 16384);
    LAS float* lrs = bcum + 4096;
    LAS float* tot = lrs + 1024;
    const int vt = w >> 2, dt = w & 3;
    f32x4 acc = (f32x4){0.f, 0.f, 0.f, 0.f};
    for (int n = 0; n < 32; ++n) {
        const size_t row0 = (size_t)b * 2048 + n * 64;
        gla_gk_cumsum(F, h, row0, bcum, lrs, tot);
        if (t < 256) { const int d8 = t >> 5, jp = t & 31;
            const bf16* kg = F.PROJ + row0 * NPROJ + C_KG + h * 64 + d8 * 8;
            const v4u a = *(const v4u*)(kg + (size_t)(2 * jp) * NPROJ), bb = *(const v4u*)(kg + (size_t)(2 * jp + 1) * NPROJ);
#pragma unroll
            for (int e = 0; e < 4; ++e) {
                const int d0 = d8 * 8 + 2 * e;
                const float bl0 = bcum[63 * 64 + d0], bl1 = bcum[63 * 64 + d0 + 1];
                const float ea0 = __expf(bl0 - bcum[(2 * jp) * 64 + d0]), eb0 = __expf(bl0 - bcum[(2 * jp + 1) * 64 + d0]);
                const float ea1 = __expf(bl1 - bcum[(2 * jp) * 64 + d0 + 1]), eb1 = __expf(bl1 - bcum[(2 * jp + 1) * 64 + d0 + 1]);
                *(LAS unsigned*)(Kt + d0 * 72 + 2 * jp) = pk2(bf2f(a[e] & 0xffffu) * ea0, bf2f(bb[e] & 0xffffu) * eb0);
                *(LAS unsigned*)(Kt + (d0 + 1) * 72 + 2 * jp) = pk2(bf2f(a[e] >> 16) * ea1, bf2f(bb[e] >> 16) * eb1);
            } }
        else if (t < 384) { const int u = t - 256, v8 = u >> 5, jp = u & 31;
            const bf16* vg = F.PROJ + row0 * NPROJ + C_VG + h * 128 + s * 32 + v8 * 8;
            const v4u a = *(const v4u*)(vg + (size_t)(2 * jp) * NPROJ), bb = *(const v4u*)(vg + (size_t)(2 * jp + 1) * NPROJ);
#pragma unroll
            for (int e = 0; e < 4; ++e) {
                *(LAS unsigned*)(Vt + (v8 * 8 + 2 * e) * 72 + 2 * jp) = (a[e] & 0xffffu) | (bb[e] << 16);
                *(LAS unsigned*)(Vt + (v8 * 8 + 2 * e + 1) * 72 + 2 * jp) = (a[e] >> 16) | (bb[e] & 0xffff0000u);
            } }
        { bf16* sp = F.SGLA + (size_t)((b * 4 + h) * 32 + n) * 8192;
#pragma unroll
          for (int r = 0; r < 4; ++r) sp[(s * 32 + 16 * vt + quad * 4 + r) * 64 + 16 * dt + l15] = f2bf(acc[r]); }
        __syncthreads();
        acc = acc * __expf(bcum[63 * 64 + 16 * dt + l15]);
#pragma unroll
        for (int ks = 0; ks < 2; ++ks) acc = MFMA16(frag(Vt, 16 * vt + l15, ks * 32 + quad * 8, 72), frag(Kt, 16 * dt + l15, ks * 32 + quad * 8, 72), acc);
    }
    float* so = F.out + O_SGP + (size_t)(b * 4 + h) * 8192;
#pragma unroll
    for (int r = 0; r < 4; ++r) so[(16 * dt + l15) * 128 + s * 32 + 16 * vt + quad * 4 + r] = acc[r];
    __syncthreads();
}
template <int DK, bool GLA> __device__ __forceinline__ void sample_item(const Frame& F, int bs, int h, LAS unsigned char* lds) {
    const int t = threadIdx.x, lane = t & 63, w = t >> 6;
    LAS float* qs = (LAS float*)lds;
    LAS float* ks = qs + 8 * DK;
    LAS float* dc = ks + 8 * DK;
    LAS float* vs = dc + 8 * DK;
    LAS float* part = vs + 8 * 128;
    LAS float* lrs = part + 4 * 8 * 128;
    const size_t row0 = (size_t)NTOKP + bs * 8;
    const int qcol = GLA ? C_QG + h * 64 : C_QR + h * 128, kcol = GLA ? C_KG + h * 64 : C_KR + h * 128;
    const int vcol = GLA ? C_VG + h * 128 : C_VR + h * 128, gcol = GLA ? C_GG + h * 128 : C_GR + h * 128;
    for (int idx = t; idx < 8 * DK; idx += NTHR) { const int tok = idx / DK, d = idx % DK;
        qs[idx] = bf2f(F.PROJ[(row0 + tok) * NPROJ + qcol + d]); ks[idx] = bf2f(F.PROJ[(row0 + tok) * NPROJ + kcol + d]); }
    for (int idx = t; idx < 8 * 128; idx += NTHR) { const int tok = idx >> 7, v = idx & 127; vs[idx] = bf2f(F.PROJ[(row0 + tok) * NPROJ + vcol + v]); }
    if (GLA) { if (t < 128) lrs[t] = bf2f(F.PROJ[(row0 + (t >> 4)) * NPROJ + C_LR + (t & 15)]); }
    __syncthreads();
    if (GLA) { const int tok = t >> 6, d = t & 63; float z = F.b_gk[h * 64 + d];
#pragma unroll
        for (int r = 0; r < 16; ++r) z += lrs[tok * 16 + r] * F.w_gk[r * 256 + h * 64 + d];
        dc[t] = __expf(logsig16(z));
        __syncthreads(); }
    constexpr int DPT = DK / 4;
    const int v = t & 127, dq = t >> 7, d0 = dq * DPT;
    const float* S0 = (GLA ? F.st_gla : F.st_ret) + (size_t)(bs * 4 + h) * DK * 128;
    float* So = F.out + (GLA ? O_SGS : O_SRS) + (size_t)(bs * 4 + h) * DK * 128;
    float S[DPT];
#pragma unroll
    for (int i = 0; i < DPT; ++i) S[i] = S0[(d0 + i) * 128 + v];
    const float gam = 1.0f - exp2f(-5.0f - (float)h);
#pragma unroll
    for (int tok = 0; tok < 8; ++tok) { const float vv = vs[tok * 128 + v]; float po = 0.f;
#pragma unroll
        for (int i4 = 0; i4 < DPT; i4 += 4) {
            const f32x4 kk = *(const LAS f32x4*)(ks + tok * DK + d0 + i4), qq = *(const LAS f32x4*)(qs + tok * DK + d0 + i4);
            f32x4 dd = (f32x4){gam, gam, gam, gam}; if (GLA) dd = *(const LAS f32x4*)(dc + tok * DK + d0 + i4);
#pragma unroll
            for (int e = 0; e < 4; ++e) { S[i4 + e] = dd[e] * S[i4 + e] + kk[e] * vv; po += qq[e] * S[i4 + e]; } }
        part[(dq * 8 + tok) * 128 + v] = po; }
#pragma unroll
    for (int i = 0; i < DPT; ++i) So[(d0 + i) * 128 + v] = S[i];
    __syncthreads();
    { const int tok = w; const size_t row = row0 + tok; const float* gain = (GLA ? F.gla_norm : F.ret_norm) + h * 128;
      float o[2];
#pragma unroll
      for (int q = 0; q < 2; ++q) { const int vv = lane + 64 * q; o[q] = part[(0 * 8 + tok) * 128 + vv] + part[(1 * 8 + tok) * 128 + vv] + part[(2 * 8 + tok) * 128 + vv] + part[(3 * 8 + tok) * 128 + vv]; }
      const float ss = wave_sum(o[0] * o[0] + o[1] * o[1]);
      const float rstd = rsqrtf(ss * (1.0f / 128.0f) + 1e-6f);
#pragma unroll
      for (int q = 0; q < 2; ++q) { const int vv = lane + 64 * q; const float g = bf2f(F.PROJ[row * NPROJ + gcol + vv]);
          F.MIX[row * DM + (GLA ? 512 : 0) + h * 128 + vv] = f2bf(o[q] * rstd * gain[vv] * silu_f(g)); } }
    __syncthreads();
}
__device__ __forceinline__ void ret_pass2(const Frame& F, int item, LAS unsigned char* lds) {
    const int b = item >> 6, h = (item >> 4) & 3, n = item & 15;
    const int t = threadIdx.x, lane = t & 63, w = __builtin_amdgcn_readfirstlane(t >> 6), l15 = lane & 15, quad = lane >> 4;
    LAS bf16* Qs = (LAS bf16*)lds; LAS bf16* Ks = Qs + 128 * 136; LAS bf16* Vt = Ks + 128 * 136; LAS bf16* St = Vt + 128 * 136;
    const size_t row0 = (size_t)b * 2048 + n * 128;
    tile_g2l<128, 16>(F.PROJ + row0 * NPROJ + C_QR + h * 128, NPROJ, Qs, 136);
    tile_g2l<128, 16>(F.PROJ + row0 * NPROJ + C_KR + h * 128, NPROJ, Ks, 136);
    tile_g2l<128, 16>(F.SRET + (size_t)((b * 4 + h) * 16 + n) * 16384, 128, St, 136);
    tile_g2l_T<128, 16>(F.PROJ + row0 * NPROJ + C_VR + h * 128, NPROJ, Vt, 136);
    __syncthreads();
    const float lg2 = log1pf(-exp2f(-5.0f - (float)h)) * 1.4426950408889634f;
    const int i0 = 16 * w;
    bf16x8 qa[4];
#pragma unroll
    for (int ks = 0; ks < 4; ++ks) qa[ks] = frag(Qs, i0 + l15, ks * 32 + quad * 8, 136);
    f32x4 acc[8];
#pragma unroll
    for (int vt = 0; vt < 8; ++vt) { acc[vt] = (f32x4){0.f, 0.f, 0.f, 0.f};
#pragma unroll
        for (int ks = 0; ks < 4; ++ks) acc[vt] = MFMA16(qa[ks], frag(St, 16 * vt + l15, ks * 32 + quad * 8, 136), acc[vt]); }
    { f32x4 sc;
#pragma unroll
      for (int r = 0; r < 4; ++r) sc[r] = __builtin_amdgcn_exp2f(lg2 * (float)(i0 + quad * 4 + r + 1));
#pragma unroll
      for (int vt = 0; vt < 8; ++vt) acc[vt] = acc[vt] * sc; }
    LAS bf16* At = Qs + i0 * 136;
    asm volatile("s_waitcnt lgkmcnt(0)" ::: "memory");
    const int njt = (w | 1) + 1;
    for (int jt = 0; jt < njt; ++jt) {
        f32x4 sv = (f32x4){0.f, 0.f, 0.f, 0.f};
        if (jt <= w) {
#pragma unroll
            for (int ks = 0; ks < 4; ++ks) sv = MFMA16(qa[ks], frag(Ks, 16 * jt + l15, ks * 32 + quad * 8, 136), sv); }
#pragma unroll
        for (int r = 0; r < 4; ++r) { const int diff = (i0 + quad * 4 + r) - (16 * jt + l15);
            const float val = diff >= 0 ? sv[r] * __builtin_amdgcn_exp2f(lg2 * (float)diff) : 0.f;
            At[(quad * 4 + r) * 136 + 16 * jt + l15] = f2bf(val); }
    }
    asm volatile("s_waitcnt lgkmcnt(0)" ::: "memory");
    const int nks = (w >> 1) + 1;
    for (int ks = 0; ks < nks; ++ks) { const bf16x8 aa = frag(At, l15, ks * 32 + quad * 8, 136);
#pragma unroll
        for (int vt = 0; vt < 8; ++vt) acc[vt] = MFMA16(aa, frag(Vt, 16 * vt + l15, ks * 32 + quad * 8, 136), acc[vt]); }
    f32x4 ss = (f32x4){0.f, 0.f, 0.f, 0.f};
#pragma unroll
    for (int vt = 0; vt < 8; ++vt) ss += acc[vt] * acc[vt];
#pragma unroll
    for (int r = 0; r < 4; ++r) { float v = ss[r]; v += __shfl_xor(v, 1); v += __shfl_xor(v, 2); v += __shfl_xor(v, 4); v += __shfl_xor(v, 8); ss[r] = rsqrtf(v * (1.0f / 128.0f) + 1e-6f); }
#pragma unroll
    for (int vt = 0; vt < 8; ++vt) { const int col = h * 128 + 16 * vt + l15; const float gn = F.ret_norm[col];
#pragma unroll
        for (int r = 0; r < 4; ++r) { const size_t row = row0 + i0 + quad * 4 + r; const float g = bf2f(F.PROJ[row * NPROJ + C_GR + col]);
            F.MIX[row * DM + col] = f2bf(acc[vt][r] * ss[r] * gn * silu_f(g)); } }
    __syncthreads();
}
__device__ __forceinline__ void gla_pass2(const Frame& F, int item, LAS unsigned char* lds) {
    const int b = item >> 7, h = (item >> 5) & 3, n = item & 31;
    const int t = threadIdx.x, lane = t & 63, w = __builtin_amdgcn_readfirstlane(t >> 6), l15 = lane & 15, quad = lane >> 4;
    LAS bf16* Qs = (LAS bf16*)lds;
    LAS bf16* Ks = Qs + 64 * 72;
    LAS bf16* Vt = Ks + 64 * 72;
    LAS bf16* St = Vt + 128 * 72;
    LAS bf16* Aw = St + 128 * 72;
    LAS float* bcum = (LAS float*)(lds + 73728);
    LAS float* lrs = bcum + 4096;
    LAS float* tot = lrs + 1024;
    LAS float* ssx = tot + 512;
    const size_t row0 = (size_t)b * 2048 + n * 64;
    tile_g2l_T<64, 16>(F.PROJ + row0 * NPROJ + C_VG + h * 128, NPROJ, Vt, 72);
    tile_g2l<128, 8>(F.SGLA + (size_t)((b * 4 + h) * 32 + n) * 8192, 64, St, 72);
    gla_gk_cumsum(F, h, row0, bcum, lrs, tot);
    { const int i = t >> 3, d8 = (t & 7) * 8;
      const v4u q = *(const v4u*)(F.PROJ + (row0 + i) * NPROJ + C_QG + h * 64 + d8), k = *(const v4u*)(F.PROJ + (row0 + i) * NPROJ + C_KG + h * 64 + d8);
      const f32x4 b0 = *(const LAS f32x4*)(bcum + i * 64 + d8), b1 = *(const LAS f32x4*)(bcum + i * 64 + d8 + 4);
      v4u qo, ko;
#pragma unroll
      for (int e = 0; e < 4; ++e) { const float ba = e < 2 ? b0[2 * e] : b1[2 * e - 4], bb = e < 2 ? b0[2 * e + 1] : b1[2 * e - 3];
          const float ea = __expf(ba), eb = __expf(bb);
          qo[e] = pk2(bf2f(q[e] & 0xffffu) * ea, bf2f(q[e] >> 16) * eb);
          ko[e] = pk2(bf2f(k[e] & 0xffffu) * __builtin_amdgcn_rcpf(ea), bf2f(k[e] >> 16) * __builtin_amdgcn_rcpf(eb)); }
      *(LAS v4u*)(Qs + i * 72 + d8) = qo; *(LAS v4u*)(Ks + i * 72 + d8) = ko; }
    __syncthreads();
    const int rt = w & 3, vh = w >> 2, i0 = 16 * rt;
    bf16x8 qa[2];
#pragma unroll
    for (int ks = 0; ks < 2; ++ks) qa[ks] = frag(Qs, i0 + l15, ks * 32 + quad * 8, 72);
    f32x4 acc[4];
#pragma unroll
    for (int v4 = 0; v4 < 4; ++v4) { acc[v4] = (f32x4){0.f, 0.f, 0.f, 0.f};
#pragma unroll
        for (int ks = 0; ks < 2; ++ks) acc[v4] = MFMA16(qa[ks], frag(St, 16 * (vh * 4 + v4) + l15, ks * 32 + quad * 8, 72), acc[v4]); }
    LAS bf16* At = Aw + w * 16 * 72;
    const int njt = (rt | 1) + 1;
    for (int jt = 0; jt < njt; ++jt) {
        f32x4 sv = (f32x4){0.f, 0.f, 0.f, 0.f};
        if (jt <= rt) {
#pragma unroll
            for (int ks = 0; ks < 2; ++ks) sv = MFMA16(qa[ks], frag(Ks, 16 * jt + l15, ks * 32 + quad * 8, 72), sv); }
#pragma unroll
        for (int r = 0; r < 4; ++r) { const int diff = (i0 + quad * 4 + r) - (16 * jt + l15);
            At[(quad * 4 + r) * 72 + 16 * jt + l15] = f2bf(diff >= 0 ? sv[r] : 0.f); }
    }
    asm volatile("s_waitcnt lgkmcnt(0)" ::: "memory");
    const int nks = (rt >> 1) + 1;
    for (int ks = 0; ks < nks; ++ks) { const bf16x8 aa = frag(At, l15, ks * 32 + quad * 8, 72);
#pragma unroll
        for (int v4 = 0; v4 < 4; ++v4) acc[v4] = MFMA16(aa, frag(Vt, 16 * (vh * 4 + v4) + l15, ks * 32 + quad * 8, 72), acc[v4]); }
    f32x4 ss = (f32x4){0.f, 0.f, 0.f, 0.f};
#pragma unroll
    for (int v4 = 0; v4 < 4; ++v4) ss += acc[v4] * acc[v4];
#pragma unroll
    for (int r = 0; r < 4; ++r) { float v = ss[r]; v += __shfl_xor(v, 1); v += __shfl_xor(v, 2); v += __shfl_xor(v, 4); v += __shfl_xor(v, 8); ss[r] = v; }
    if (l15 == 0) { ssx[w * 16 + quad * 4 + 0] = ss[0]; ssx[w * 16 + quad * 4 + 1] = ss[1]; ssx[w * 16 + quad * 4 + 2] = ss[2]; ssx[w * 16 + quad * 4 + 3] = ss[3]; }
    __syncthreads();
#pragma unroll
    for (int r = 0; r < 4; ++r) ss[r] = rsqrtf((ssx[w * 16 + quad * 4 + r] + ssx[(w ^ 4) * 16 + quad * 4 + r]) * (1.0f / 128.0f) + 1e-6f);
#pragma unroll
    for (int v4 = 0; v4 < 4; ++v4) { const int hv = h * 128 + 16 * (vh * 4 + v4) + l15; const float gn = F.gla_norm[hv];
#pragma unroll
        for (int r = 0; r < 4; ++r) { const size_t row = row0 + i0 + quad * 4 + r; const float g = bf2f(F.PROJ[row * NPROJ + C_GG + hv]);
            F.MIX[row * DM + 512 + hv] = f2bf(acc[v4][r] * ss[r] * gn * silu_f(g)); } }
    __syncthreads();
}
#ifndef MK_N_LAUNCHES
#define MK_N_LAUNCHES 1
#endif
constexpr int N_PHASES = 10;
struct Args { const float* in[19]; float* out; unsigned char* ws; int ph_lo, ph_hi; };
__global__ void __launch_bounds__(NTHR, 2) hybrid_fwd(Args a) {
    extern __shared__ __attribute__((aligned(16))) unsigned char lds_raw[];
    LAS unsigned char* lds = (LAS unsigned char*)lds_raw;
    cg::grid_group grid = cg::this_grid();
    Frame F;
    F.x_p = a.in[0]; F.x_s = a.in[1]; F.st_ret = a.in[2]; F.st_gla = a.in[3]; F.c_p = a.in[4]; F.c_s = a.in[5]; F.w_ada = a.in[6]; F.b_ada = a.in[7]; F.mix_norm = a.in[8];
    F.w_in = a.in[9]; F.w_gk = a.in[10]; F.b_gk = a.in[11]; F.ret_norm = a.in[12]; F.gla_norm = a.in[13]; F.w_out = a.in[14]; F.ffn_norm = a.in[15]; F.w_gu = a.in[16];
    F.w_dn = a.in[17]; F.fin_norm = a.in[18]; F.out = a.out; F.ws = a.ws;
    F.WIN = (bf16*)(a.ws + WS_WIN); F.WOUT = (bf16*)(a.ws + WS_WOUT); F.WGU = (bf16*)(a.ws + WS_WGU); F.WDN = (bf16*)(a.ws + WS_WDN);
    F.H = (bf16*)(a.ws + WS_H); F.MIX = (bf16*)(a.ws + WS_MIX); F.PROJ = (bf16*)(a.ws + WS_PROJ); F.HID = (bf16*)(a.ws + WS_HID);
    F.SRET = (bf16*)(a.ws + WS_SRET); F.SGLA = (bf16*)(a.ws + WS_SGLA);
    F.MOD = (float*)(a.ws + WS_MOD); F.RC = (float*)(a.ws + WS_ROPE); F.RS = F.RC + ROPE_ROWS * 64;
    const int G = gridDim.x, bx = blockIdx.x, lo = a.ph_lo, hi = a.ph_hi;
#define IN(k) (lo <= (k) && (k) < hi)
#define SEAM(k) do { if (IN(k) && IN((k) + 1)) grid.sync(); } while (0)
    if (IN(0)) p0_prologue(F, lds);
    SEAM(0);
    if (IN(1)) norm_phase<true>(F.x_p, F.x_s, F.mix_norm, F.MOD, 0, 1, F.H, nullptr);
    SEAM(1);
    if (IN(2)) { pg8::Gemm g{F.H, F.WIN, NTOK, NPROJ, DM}; pg8::StaticOrder S; S.init(NTOK, NPROJ, G, bx); pg8::EpiProj E{F.PROJ, F.RC, F.RS};
        pg8::gemm_phase<pg8::EpiProj, pg8::StaticOrder, true, true>(lds, g, S, E); }
    SEAM(2);
    if (IN(3)) {
        for (int it = bx; it < 256; it += G) { if (it < 128) ret_pass1(F, it, lds); else gla_pass1(F, it - 128, lds); }
        for (int j = bx; j < 1024; j += G) { if (j < 512) sample_item<128, false>(F, j >> 2, j & 3, lds); else sample_item<64, true>(F, (j - 512) >> 2, j & 3, lds); }
    }
    SEAM(3);
    if (IN(4)) { for (int it = bx; it < 1536; it += G) { if (it < 512) ret_pass2(F, it, lds); else gla_pass2(F, it - 512, lds); } }
    SEAM(4);
    if (IN(5)) { pg8::Gemm g{F.MIX, F.WOUT, NTOK, DM, DM}; pg8::StaticOrder S; S.init(NTOK, DM, G, bx); pg8::EpiRes E{F.x_p, F.x_s, F.out, F.MOD + 2 * DM};
        pg8::gemm_phase<pg8::EpiRes, pg8::StaticOrder, true, true>(lds, g, S, E); }
    SEAM(5);
    if (IN(6)) norm_phase<true>(F.out, F.out + (size_t)NTOKP * DM, F.ffn_norm, F.MOD, 3, 4, F.H, nullptr);
    SEAM(6);
    if (IN(7)) { pg8::Gemm g{F.H, F.WGU, NTOK, 2 * DFF, DM}; pg8::StaticOrder S; S.init(NTOK, 2 * DFF, G, bx); pg8::EpiSwiGLU E{F.HID};
        pg8::gemm_phase<pg8::EpiSwiGLU, pg8::StaticOrder, true, true>(lds, g, S, E); }
    SEAM(7);
    if (IN(8)) { pg8::Gemm g{F.HID, F.WDN, NTOK, DM, DFF}; pg8::StaticOrder S; S.init(NTOK, DM, G, bx); pg8::EpiRes E{F.out, F.out + (size_t)NTOKP * DM, F.out, F.MOD + 5 * DM};
        pg8::gemm_phase<pg8::EpiRes, pg8::StaticOrder, true, true>(lds, g, S, E); }
    SEAM(8);
    if (IN(9)) norm_phase<false>(F.out, F.out + (size_t)NTOKP * DM, F.fin_norm, nullptr, 0, 0, nullptr, F.out);
#undef IN
#undef SEAM
}

extern "C" void kernel_launch(void* const* d_in, const int* in_sizes, int n_in, void* d_out, int out_size, void* d_ws, size_t ws_size, hipStream_t stream) {
    static int grid = 0;
    if (grid == 0) {
        int dev = 0, cus = 0, per_cu = 0;
        if (n_in != 19 || ws_size < WS_END) { fprintf(stderr, "kernel_launch: unexpected n_in %d / ws %zu\n", n_in, ws_size); grid = -1; return; }
        (void)hipGetDevice(&dev);
        (void)hipDeviceGetAttribute(&cus, hipDeviceAttributeMultiprocessorCount, dev);
        (void)hipFuncSetAttribute((const void*)hybrid_fwd, hipFuncAttributeMaxDynamicSharedMemorySize, LDS_BYTES);
        (void)hipOccupancyMaxActiveBlocksPerMultiprocessor(&per_cu, (const void*)hybrid_fwd, NTHR, LDS_BYTES);
        if (per_cu < 1) { fprintf(stderr, "kernel_launch: occupancy query reports %d blocks per CU\n", per_cu); grid = -1; return; }
        grid = cus;
        if (grid > 256) grid = 256;
    }
    if (grid < 0) return;
    Args a{};
    for (int i = 0; i < 19; ++i) a.in[i] = (const float*)d_in[i];
    a.out = (float*)d_out; a.ws = (unsigned char*)d_ws;
#if MK_N_LAUNCHES == 1
    a.ph_lo = 0; a.ph_hi = N_PHASES;
    void* args[] = {&a};
    hipError_t e = hipLaunchCooperativeKernel((void*)hybrid_fwd, dim3(grid), dim3(NTHR), args, LDS_BYTES, stream);
    if (e != hipSuccess) fprintf(stderr, "cooperative launch failed: %s (grid %d)\n", hipGetErrorString(e), grid);
#else
    for (int p = 0; p < N_PHASES; ++p) { a.ph_lo = p; a.ph_hi = p + 1; hipLaunchKernelGGL(hybrid_fwd, dim3(grid), dim3(NTHR), LDS_BYTES, stream, a); }
#endif
}
```

```cpp
#include <hip/hip_runtime.h>
#include <hip/hip_cooperative_groups.h>
#include <cstdio>
#include <cstdint>
namespace cg = cooperative_groups;

constexpr int NTOKP = 16384, NTOK = 17408, DM = 1024, NPROJ = 3840, DFF = 2816, MODW = 6144;
__device__ __forceinline__ int row_seq(int row) { return row < NTOKP ? (row >> 11) : 8 + ((row - NTOKP) >> 3); }
__device__ __forceinline__ int row_rope(int row) { return row < NTOKP ? (row & 2047) : 2048 + ((row - NTOKP) & 7); }
namespace pg8 {
#define PG8_LAS __attribute__((address_space(3)))
typedef unsigned short bf16_t;
typedef short bf16x8 __attribute__((ext_vector_type(8)));
typedef float f32x4 __attribute__((ext_vector_type(4)));
typedef unsigned u32x4 __attribute__((ext_vector_type(4)));
constexpr int BM = 256, BK = 64, HALF = 128, HTB = HALF * BK * 2  , STAGE_BYTES = 8 * HTB, NXCD = 8, WGM = 8;

__host__ __device__ __forceinline__ int lds_byte(int r, int c) { const int st = (r >> 4) * 2 + (c >> 5), rr = r & 15, cc = c & 31, ob = rr * 64 + cc * 2; return st * 1024 + (ob ^ (((ob >> 9) & 1) << 5)); }
__host__ __device__ __forceinline__ void stage_rc(int b, int& R, int& C) { const int st = b / 1024, sb = b % 1024, swz = sb ^ (((sb >> 9) & 1) << 5); R = (st >> 1) * 16 + swz / 64; C = (st & 1) * 32 + (swz % 64) / 2; }
__host__ __device__ __forceinline__ int perm32(int rho) { const int n = rho >> 4, i = rho & 15; return 8 * (i >> 2) + 4 * n + (i & 3); }

struct Unit { int pm, pn; };
struct Gemm { const bf16_t* A; const bf16_t* Bt; int M, N, K; };

struct StaticOrder {
    int nM, nN, nwg, G, c;
    __host__ __device__ void init(int M, int N, int G_, int c_) { nM = M / BM; nN = N / BM; nwg = nM * nN; G = G_; c = c_; }
    __host__ __device__ bool next(int i, Unit& u) const {
        const long L = (long)i * G + c; if (L >= nwg) return false;
        int wgid = (int)L; { const int q = nwg / NXCD, r = nwg % NXCD, xcd = wgid % NXCD, off = wgid / NXCD; wgid = (xcd < r ? xcd * (q + 1) : r * (q + 1) + (xcd - r) * q) + off; }
        const int nig = WGM * nN, gid = wgid / nig, fm = gid * WGM, gsz = (nM - fm) < WGM ? (nM - fm) : WGM;
        u.pm = fm + ((wgid % nig) % gsz); u.pn = (wgid % nig) / gsz; return true;
    }
    __device__ __forceinline__ void a_ready(const Unit&) const {}
    __device__ __forceinline__ void done(const Unit&) const {}
};

__device__ __forceinline__ unsigned cvt_pk_bf16(float lo, float hi) { unsigned r; asm volatile("v_cvt_pk_bf16_f32 %0, %1, %2" : "=v"(r) : "v"(lo), "v"(hi)); return r; }
struct EpiProj {
    static constexpr bool PERM = true, AFTER_DRAIN = false;
    bf16_t* O; const float* cs; const float* sn;
    __device__ __forceinline__ void operator()(const f32x4 (&acc)[2][2][4][2], const Unit& u, int wr, int wc, int fr, int fq) const {
        const int row0 = u.pm * BM + wr * 64 + fr;
        if (u.pn < 4) {
            const int hl = wc >> 1, f0 = 32 * (wc & 1) + 8 * fq;
            const float scale = (u.pn >= 2) ? 0.08838834764831845f : 1.0f;
            const int colbase = u.pn * 256 + hl * 128 + f0;
#pragma unroll
            for (int ai = 0; ai < 2; ++ai)
#pragma unroll
                for (int m = 0; m < 4; ++m) {
                    const int row = row0 + ai * HALF + m * 16; const int pr = row_rope(row);
                    const f32x4 c0 = *(const f32x4*)(cs + pr * 64 + f0), c1 = *(const f32x4*)(cs + pr * 64 + f0 + 4);
                    const f32x4 s0 = *(const f32x4*)(sn + pr * 64 + f0), s1 = *(const f32x4*)(sn + pr * 64 + f0 + 4);
                    const f32x4 x10 = acc[ai][0][m][0], x11 = acc[ai][0][m][1], x20 = acc[ai][1][m][0], x21 = acc[ai][1][m][1];
                    const f32x4 a0 = (x10 * c0 - x20 * s0) * scale, a1 = (x11 * c1 - x21 * s1) * scale;
                    const f32x4 b0 = (x10 * s0 + x20 * c0) * scale, b1 = (x11 * s1 + x21 * c1) * scale;
                    bf16_t* rowp = O + (size_t)row * NPROJ + colbase;
                    u32x4 w; w.x = cvt_pk_bf16(a0[0], a0[1]); w.y = cvt_pk_bf16(a0[2], a0[3]); w.z = cvt_pk_bf16(a1[0], a1[1]); w.w = cvt_pk_bf16(a1[2], a1[3]);
                    *(u32x4*)rowp = w;
                    w.x = cvt_pk_bf16(b0[0], b0[1]); w.y = cvt_pk_bf16(b0[2], b0[3]); w.z = cvt_pk_bf16(b1[0], b1[1]); w.w = cvt_pk_bf16(b1[2], b1[3]);
                    *(u32x4*)(rowp + 64) = w;
                }
        } else {
            const float sc = (u.pn == 8) ? 0.125f : 1.0f;
            const int col0 = u.pn * BM + wc * 32 + 8 * fq;
#pragma unroll
            for (int ai = 0; ai < 2; ++ai)
#pragma unroll
                for (int m = 0; m < 4; ++m) { bf16_t* rowp = O + (size_t)(row0 + ai * HALF + m * 16) * NPROJ + col0;
#pragma unroll
                    for (int bj = 0; bj < 2; ++bj) { const f32x4 v0 = acc[ai][bj][m][0] * sc, v1 = acc[ai][bj][m][1] * sc;
                        u32x4 w; w.x = cvt_pk_bf16(v0[0], v0[1]); w.y = cvt_pk_bf16(v0[2], v0[3]); w.z = cvt_pk_bf16(v1[0], v1[1]); w.w = cvt_pk_bf16(v1[2], v1[3]);
                        *(u32x4*)(rowp + bj * HALF) = w; } }
        }
    }
};
struct EpiRes {
    static constexpr bool PERM = false, AFTER_DRAIN = false;
    const float* base_p; const float* base_s; float* out; const float* gate;
    __device__ __forceinline__ void operator()(const f32x4 (&acc)[2][2][4][2], const Unit& u, int wr, int wc, int fr, int fq) const {
        const int row0 = u.pm * BM + wr * 64 + fr, col0 = u.pn * BM + wc * 32 + 4 * fq;
#pragma unroll
        for (int ai = 0; ai < 2; ++ai)
#pragma unroll
            for (int m = 0; m < 4; ++m) {
                const int row = row0 + ai * HALF + m * 16;
                const float* brow = row < NTOKP ? base_p + (size_t)row * DM : base_s + (size_t)(row - NTOKP) * DM;
                const float* g = gate + (size_t)row_seq(row) * MODW;
                float* orow = out + (size_t)row * DM;
#pragma unroll
                for (int bj = 0; bj < 2; ++bj)
#pragma unroll
                    for (int n = 0; n < 2; ++n) { const int c = col0 + bj * HALF + n * 16;
                        const f32x4 bv = *(const f32x4*)(brow + c), gv = *(const f32x4*)(g + c);
                        *(f32x4*)(orow + c) = bv + gv * acc[ai][bj][m][n]; }
            }
    }
};
struct EpiSwiGLU {
    static constexpr bool PERM = true, AFTER_DRAIN = false;
    bf16_t* O;
    __device__ __forceinline__ void operator()(const f32x4 (&acc)[2][2][4][2], const Unit& u, int wr, int wc, int fr, int fq) const {
        const int row0 = u.pm * BM + wr * 64 + fr, col0 = u.pn * HALF + wc * 32 + 8 * fq;
#pragma unroll
        for (int ai = 0; ai < 2; ++ai)
#pragma unroll
            for (int m = 0; m < 4; ++m) {
                float v[8];
#pragma unroll
                for (int n = 0; n < 2; ++n)
#pragma unroll
                    for (int e = 0; e < 4; ++e) { const float a = acc[ai][0][m][n][e], b = acc[ai][1][m][n][e];
                        v[n * 4 + e] = a * __builtin_amdgcn_rcpf(1.0f + __expf(-a)) * b; }
                u32x4 w; w.x = cvt_pk_bf16(v[0], v[1]); w.y = cvt_pk_bf16(v[2], v[3]); w.z = cvt_pk_bf16(v[4], v[5]); w.w = cvt_pk_bf16(v[6], v[7]);
                *(u32x4*)(O + (size_t)(row0 + ai * HALF + m * 16) * DFF + col0) = w;
            }
    }
};

template <class Epi, class Sched, bool ALIGN_EPI = false, bool SP2 = false>
__device__ __forceinline__ void gemm_phase(PG8_LAS unsigned char* lds, const Gemm g, const Sched& S, const Epi& E) {
    const int tid = threadIdx.x, wid = __builtin_amdgcn_readfirstlane(tid >> 6), lane = tid & 63, wr = wid >> 2, wc = wid & 3, fr = lane & 15, fq = lane >> 4;
    const int K = g.K, nt = K / BK;
    unsigned voffA[2], voffB[2];
#pragma unroll
    for (int i = 0; i < 2; ++i) { int R, C; stage_rc(tid * 16 + i * 8192, R, C); const int Rb = Epi::PERM ? ((R & ~31) + perm32(R & 31)) : R;
        voffA[i] = (unsigned)(R * K + C) * 2u; voffB[i] = (unsigned)(Rb * K + C) * 2u; }
    const size_t kstep = (size_t)(BK * 2);
    const size_t hstep = (size_t)HALF * K * 2;
    const size_t tstep = 2 * hstep;
    const unsigned ldsw = (unsigned)wid * 1024u;
    const int aoff = lds_byte(wr * 64 + fr, fq * 8), boff = lds_byte(wc * 32 + fr, fq * 8);
#define PG8_SA(b, h) (((b) * 2 + (h)) * HTB)
#define PG8_SB(b, h) ((4 + (b) * 2 + (h)) * HTB)
#define PG8_STAGE(bufoff, gbase, voff) do { _Pragma("unroll") for (int _i = 0; _i < 2; ++_i) \
        __builtin_amdgcn_global_load_lds((const unsigned*)((const char*)(gbase) + (voff)[_i]), (PG8_LAS unsigned*)(lds + (bufoff) + ldsw + _i * 8192), 16, 0, 0); } while (0)
#define PG8_LDA(dst, b, h) do { _Pragma("unroll") for (int m = 0; m < 4; ++m) _Pragma("unroll") for (int k = 0; k < 2; ++k) dst[m][k] = *(const PG8_LAS bf16x8*)(lds + PG8_SA(b, h) + aoff + m * 2048 + k * 1024); } while (0)
#define PG8_LDB(dst, b, h) do { _Pragma("unroll") for (int n = 0; n < 2; ++n) _Pragma("unroll") for (int k = 0; k < 2; ++k) dst[n][k] = *(const PG8_LAS bf16x8*)(lds + PG8_SB(b, h) + boff + n * 2048 + k * 1024); } while (0)
#define PG8_MMA(ai, bj, At, Bt) do { __builtin_amdgcn_s_setprio(1); _Pragma("unroll") for (int m = 0; m < 4; ++m) _Pragma("unroll") for (int n = 0; n < 2; ++n) _Pragma("unroll") for (int k = 0; k < 2; ++k) \
        acc[ai][bj][m][n] = __builtin_amdgcn_mfma_f32_16x16x32_bf16(Bt[n][k], At[m][k], acc[ai][bj][m][n], 0, 0, 0); __builtin_amdgcn_s_setprio(0); } while (0)
#define PG8_WAIT_V(n) asm volatile("s_waitcnt vmcnt(" #n ")" ::: "memory")
#define PG8_WAIT_L(n) asm volatile("s_waitcnt lgkmcnt(" #n ")" ::: "memory")
#define PG8_BAR __builtin_amdgcn_s_barrier()
#define PG8_SCHED __builtin_amdgcn_sched_barrier(0)
    Unit cur, nxt; int ui = 0;
    if (!S.next(0, cur)) return;
    f32x4 acc[2][2][4][2];
#pragma unroll
    for (int a = 0; a < 2; ++a)
#pragma unroll
        for (int b = 0; b < 2; ++b)
#pragma unroll
            for (int m = 0; m < 4; ++m)
#pragma unroll
                for (int n = 0; n < 2; ++n) acc[a][b][m][n] = (f32x4){0.f, 0.f, 0.f, 0.f};
    bf16x8 At[4][2], B0[2][2], B1[2][2];
    const char* cA = (const char*)g.A + (size_t)cur.pm * tstep; const char* cB = (const char*)g.Bt + (size_t)cur.pn * tstep;
    S.a_ready(cur);
    if constexpr (SP2) {
        PG8_STAGE(PG8_SB(0, 0), cB, voffB); PG8_STAGE(PG8_SB(0, 1), cB + hstep, voffB); PG8_STAGE(PG8_SA(0, 0), cA, voffA); PG8_STAGE(PG8_SA(0, 1), cA + hstep, voffA);
        if (wr == 1) PG8_BAR;
        PG8_WAIT_V(2); PG8_BAR;
        PG8_STAGE(PG8_SB(1, 0), cB + kstep, voffB); PG8_STAGE(PG8_SA(1, 0), cA + kstep, voffA); PG8_STAGE(PG8_SB(1, 1), cB + hstep + kstep, voffB);
        PG8_WAIT_V(6); PG8_BAR;
    } else {
        PG8_STAGE(PG8_SB(0, 0), cB, voffB); PG8_STAGE(PG8_SA(0, 0), cA, voffA); PG8_STAGE(PG8_SB(0, 1), cB + hstep, voffB); PG8_STAGE(PG8_SA(0, 1), cA + hstep, voffA);
        if (wr == 1) PG8_BAR;
        PG8_WAIT_V(4); PG8_BAR;
        PG8_STAGE(PG8_SB(1, 0), cB + kstep, voffB); PG8_STAGE(PG8_SA(1, 0), cA + kstep, voffA); PG8_STAGE(PG8_SB(1, 1), cB + hstep + kstep, voffB);
        PG8_WAIT_V(6); PG8_BAR;
    }
    for (;;) {
        const bool has_next = S.next(ui + 1, nxt);
        const char* nA = has_next ? (const char*)g.A + (size_t)nxt.pm * tstep : cA; const char* nB = has_next ? (const char*)g.Bt + (size_t)nxt.pn * tstep : cB;
        for (int t = 0; t < nt; t += 2) {
            const bool last = (t == nt - 2);
            const char* a1 = cA + (size_t)(t + 1) * kstep;
            const char* a2 = last ? nA : cA + (size_t)(t + 2) * kstep; const char* b2 = last ? nB : cB + (size_t)(t + 2) * kstep;
            const char* a3 = a2 + kstep; const char* b3 = b2 + kstep;
            if (last && has_next) S.a_ready(nxt);
            if constexpr (SP2) {
            PG8_LDB(B0, 0, 0); PG8_LDB(B1, 0, 1); PG8_SCHED; PG8_LDA(At, 0, 0); PG8_STAGE(PG8_SA(1, 1), a1 + hstep, voffA);
            PG8_WAIT_V(8); PG8_WAIT_L(0); PG8_BAR; PG8_MMA(0, 0, At, B0); PG8_MMA(0, 1, At, B1); PG8_BAR; PG8_SCHED;
            PG8_LDA(At, 0, 1); PG8_STAGE(PG8_SB(0, 0), b2, voffB); PG8_STAGE(PG8_SB(0, 1), b2 + hstep, voffB); PG8_STAGE(PG8_SA(0, 0), a2, voffA);
            PG8_WAIT_V(8); PG8_WAIT_L(0); PG8_BAR; PG8_MMA(1, 0, At, B0); PG8_MMA(1, 1, At, B1); PG8_BAR; PG8_SCHED;
            PG8_LDB(B0, 1, 0); PG8_LDB(B1, 1, 1); PG8_SCHED; PG8_LDA(At, 1, 0); PG8_STAGE(PG8_SA(0, 1), a2 + hstep, voffA);
            PG8_WAIT_V(8); PG8_WAIT_L(0); PG8_BAR; PG8_MMA(0, 0, At, B0); PG8_MMA(0, 1, At, B1); PG8_BAR; PG8_SCHED;
            PG8_LDA(At, 1, 1); PG8_STAGE(PG8_SB(1, 0), b3, voffB); PG8_STAGE(PG8_SB(1, 1), b3 + hstep, voffB); PG8_STAGE(PG8_SA(1, 0), a3, voffA);
            PG8_WAIT_V(8); PG8_WAIT_L(0); PG8_BAR; PG8_MMA(1, 0, At, B0); PG8_MMA(1, 1, At, B1); PG8_BAR; PG8_SCHED;
            } else {
            PG8_LDB(B0, 0, 0); PG8_SCHED; PG8_LDA(At, 0, 0); PG8_STAGE(PG8_SA(1, 1), a1 + hstep, voffA);
            PG8_WAIT_L(8); PG8_BAR; PG8_WAIT_L(0); PG8_MMA(0, 0, At, B0); PG8_BAR; PG8_SCHED;
            PG8_LDB(B1, 0, 1); PG8_STAGE(PG8_SB(0, 0), b2, voffB);
            PG8_BAR; PG8_WAIT_L(0); PG8_MMA(0, 1, At, B1); PG8_BAR;
            PG8_LDA(At, 0, 1); PG8_STAGE(PG8_SA(0, 0), a2, voffA);
            PG8_BAR; PG8_WAIT_L(0); PG8_MMA(1, 0, At, B0); PG8_BAR; PG8_SCHED;
            PG8_STAGE(PG8_SB(0, 1), b2 + hstep, voffB);
            PG8_WAIT_V(6); PG8_BAR; PG8_MMA(1, 1, At, B1); PG8_BAR;
            PG8_LDB(B0, 1, 0); PG8_SCHED; PG8_LDA(At, 1, 0); PG8_STAGE(PG8_SA(0, 1), a2 + hstep, voffA);
            PG8_WAIT_L(8); PG8_BAR; PG8_WAIT_L(0); PG8_MMA(0, 0, At, B0); PG8_BAR; PG8_SCHED;
            PG8_LDB(B1, 1, 1); PG8_STAGE(PG8_SB(1, 0), b3, voffB);
            PG8_BAR; PG8_WAIT_L(0); PG8_MMA(0, 1, At, B1); PG8_BAR;
            PG8_LDA(At, 1, 1); PG8_STAGE(PG8_SA(1, 0), a3, voffA);
            PG8_BAR; PG8_WAIT_L(0); PG8_MMA(1, 0, At, B0); PG8_BAR; PG8_SCHED;
            PG8_STAGE(PG8_SB(1, 1), b3 + hstep, voffB);
            PG8_WAIT_V(6); PG8_BAR; PG8_MMA(1, 1, At, B1); PG8_BAR;
            }
        }
        if constexpr (ALIGN_EPI) { if (wr == 0) PG8_BAR; }
        if constexpr (!Epi::AFTER_DRAIN) { E(acc, cur, wr, wc, fr, fq); S.done(cur); }
        if (!has_next) break;
#pragma unroll
        for (int a = 0; a < 2; ++a)
#pragma unroll
            for (int b = 0; b < 2; ++b)
#pragma unroll
                for (int m = 0; m < 4; ++m)
#pragma unroll
                    for (int n = 0; n < 2; ++n) acc[a][b][m][n] = (f32x4){0.f, 0.f, 0.f, 0.f};
        cur = nxt; cA = nA; cB = nB; ++ui;
        if constexpr (ALIGN_EPI) { if (wr == 1) PG8_BAR; }
    }
    PG8_WAIT_V(0);
    if constexpr (!ALIGN_EPI) { if (wr == 0) PG8_BAR; }
    PG8_BAR;
    if constexpr (Epi::AFTER_DRAIN) { E.fused(acc, cur, wr, wc, fr, fq, lds, wid, lane); S.done(cur); }
#undef PG8_SA
#undef PG8_SB
#undef PG8_STAGE
#undef PG8_LDA
#undef PG8_LDB
#undef PG8_MMA
#undef PG8_WAIT_V
#undef PG8_WAIT_L
#undef PG8_BAR
#undef PG8_SCHED
}
}
#define LAS __attribute__((address_space(3)))
typedef unsigned short bf16;
typedef unsigned v4u __attribute__((ext_vector_type(4)));
typedef unsigned v2u __attribute__((ext_vector_type(2)));
typedef float f32x4 __attribute__((ext_vector_type(4)));
typedef short bf16x8 __attribute__((ext_vector_type(8)));
constexpr int NTHR = 512;
constexpr int LDS_BYTES = 147456;
constexpr size_t MiB = 1u << 20;
constexpr size_t WS_WIN = 1 * MiB, WS_WOUT = 9 * MiB, WS_WGU = 11 * MiB, WS_WDN = 22 * MiB, WS_MOD = 28 * MiB, WS_ROPE = 32 * MiB;
constexpr size_t WS_H = 34 * MiB, WS_MIX = 68 * MiB, WS_PROJ = 102 * MiB, WS_END = 230 * MiB;
constexpr size_t WS_SRET = WS_H, WS_SGLA = WS_H + 16 * MiB, WS_HID = WS_PROJ;
constexpr int ROPE_ROWS = 2056;
constexpr int C_QR = 0, C_KR = 512, C_VR = 1024, C_GR = 1536, C_QG = 2048, C_KG = 2304, C_VG = 2560, C_GG = 3072, C_LR = 3584;
constexpr size_t O_Y = 0, O_SRP = (size_t)NTOK * DM, O_SGP = O_SRP + 8 * 4 * 128 * 128, O_SRS = O_SGP + 8 * 4 * 64 * 128, O_SGS = O_SRS + (size_t)128 * 4 * 128 * 128;

__device__ __forceinline__ float bf2f(unsigned h) { return __uint_as_float(h << 16); }
__device__ __forceinline__ unsigned pk2(float lo, float hi) { return pg8::cvt_pk_bf16(lo, hi); }
__device__ __forceinline__ bf16 f2bf(float f) { unsigned u = __float_as_uint(f); return (bf16)((u + 0x7fffu + ((u >> 16) & 1u)) >> 16); }
__device__ __forceinline__ float wave_sum(float v) {
#pragma unroll
    for (int o = 32; o >= 1; o >>= 1) v += __shfl_xor(v, o);
    return v;
}
__device__ __forceinline__ float silu_f(float a) { return a * __builtin_amdgcn_rcpf(1.0f + __expf(-a)); }
__device__ __forceinline__ float logsig16(float z) { return (fminf(z, 0.f) - __logf(1.0f + __expf(-fabsf(z)))) * 0.0625f; }
__device__ __forceinline__ bf16x8 frag(const LAS bf16* base, int row, int kofs, int ls) { return *(const LAS bf16x8*)(base + row * ls + kofs); }
#define MFMA16(a, b, c) __builtin_amdgcn_mfma_f32_16x16x32_bf16((a), (b), (c), 0, 0, 0)

template <int R, int C8> __device__ __forceinline__ void tile_g2l(const bf16* g, size_t gp, LAS bf16* l, int ls) {
    for (int idx = threadIdx.x; idx < R * C8; idx += NTHR) { const int r = idx / C8, c = idx % C8;
        const v4u v = *(const v4u*)(g + (size_t)r * gp + c * 8); *(LAS v4u*)(l + r * ls + c * 8) = v; }
}
template <int J, int V8> __device__ __forceinline__ void tile_g2l_T(const bf16* g, size_t gp, LAS bf16* l, int ls) {
    for (int idx = threadIdx.x; idx < V8 * (J / 2); idx += NTHR) { const int v8 = idx / (J / 2), jp = idx % (J / 2);
        const v4u a = *(const v4u*)(g + (size_t)(2 * jp) * gp + v8 * 8), b = *(const v4u*)(g + (size_t)(2 * jp + 1) * gp + v8 * 8);
#pragma unroll
        for (int e = 0; e < 4; ++e) {
            *(LAS unsigned*)(l + (v8 * 8 + 2 * e) * ls + 2 * jp) = (a[e] & 0xffffu) | (b[e] << 16);
            *(LAS unsigned*)(l + (v8 * 8 + 2 * e + 1) * ls + 2 * jp) = (a[e] >> 16) | (b[e] & 0xffff0000u);
        }
    }
}

struct Frame {
    const float *x_p, *x_s, *st_ret, *st_gla, *c_p, *c_s, *w_ada, *b_ada, *mix_norm, *w_in, *w_gk, *b_gk, *ret_norm, *gla_norm, *w_out, *ffn_norm, *w_gu, *w_dn, *fin_norm;
    float* out; unsigned char* ws;
    bf16 *WIN, *WOUT, *WGU, *WDN, *H, *MIX, *PROJ, *HID, *SRET, *SGLA; float *MOD, *RC, *RS;
};

__device__ __forceinline__ void p0_transpose_item(const float* W, int ldw, bf16* WT, int K, int kind, int item, LAS float* scr) {
    const int t = threadIdx.x, nkt = K / 256, nt = item / nkt, kt = item % nkt, r0 = nt * 64;
    int src0 = r0, valid = 64;
    if (kind == 0) { if (r0 < 1024) { const int pn = r0 >> 8, within = r0 & 255, bj = within >> 7, hl = (within & 127) >> 6; src0 = pn * 256 + hl * 128 + bj * 64; }
                     else { valid = 3600 - r0; valid = valid < 0 ? 0 : (valid > 64 ? 64 : valid); } }
    else if (kind == 1) { const int pn = r0 >> 8, within = r0 & 255, bj = within >> 7, idx = within & 127; src0 = bj * DFF + pn * 128 + idx; }
    const int c4 = (t & 15) * 4;
    f32x4 v[8];
#pragma unroll
    for (int i = 0; i < 8; ++i) { const int kk = (t >> 4) + 32 * i; v[i] = (f32x4){0.f, 0.f, 0.f, 0.f};
        if (c4 < valid) v[i] = __builtin_nontemporal_load((const f32x4*)(W + (size_t)(kt * 256 + kk) * ldw + src0 + c4)); }
#pragma unroll
    for (int i = 0; i < 8; ++i) { const int kk = (t >> 4) + 32 * i;
        scr[(c4 + 0) * 264 + kk] = v[i][0]; scr[(c4 + 1) * 264 + kk] = v[i][1]; scr[(c4 + 2) * 264 + kk] = v[i][2]; scr[(c4 + 3) * 264 + kk] = v[i][3]; }
    __syncthreads();
#pragma unroll
    for (int i = 0; i < 4; ++i) { const int c = t + NTHR * i, n = c >> 5, k8 = (c & 31) * 8;
        const f32x4 a = *(const LAS f32x4*)(scr + n * 264 + k8), b = *(const LAS f32x4*)(scr + n * 264 + k8 + 4);
        v4u w; w.x = pk2(a[0], a[1]); w.y = pk2(a[2], a[3]); w.z = pk2(b[0], b[1]); w.w = pk2(b[2], b[3]);
        *(v4u*)(WT + (size_t)(r0 + n) * K + kt * 256 + k8) = w; }
    __syncthreads();
}
__device__ __forceinline__ void p0_mod_slab(const Frame& F, int slab, LAS float* red) {
    const int t = threadIdx.x, lane = t & 63, w = __builtin_amdgcn_readfirstlane(t >> 6), l15 = lane & 15, quad = lane >> 4;
    f32x4 acc[9][2];
#pragma unroll
    for (int rt = 0; rt < 9; ++rt) { acc[rt][0] = (f32x4){0.f, 0.f, 0.f, 0.f}; acc[rt][1] = acc[rt][0]; }
#pragma unroll 1
    for (int ks = 0; ks < 4; ++ks) {
        const int k0 = w * 128 + ks * 32 + quad * 8;
        bf16x8 bfr[2];
#pragma unroll
        for (int ct = 0; ct < 2; ++ct) { const float* wp = F.w_ada + (size_t)k0 * MODW + slab * 32 + ct * 16 + l15; v4u p;
            p.x = pk2(__builtin_nontemporal_load(wp), __builtin_nontemporal_load(wp + MODW)); p.y = pk2(__builtin_nontemporal_load(wp + 2 * MODW), __builtin_nontemporal_load(wp + 3 * MODW));
            p.z = pk2(__builtin_nontemporal_load(wp + 4 * MODW), __builtin_nontemporal_load(wp + 5 * MODW)); p.w = pk2(__builtin_nontemporal_load(wp + 6 * MODW), __builtin_nontemporal_load(wp + 7 * MODW));
            bfr[ct] = __builtin_bit_cast(bf16x8, p); }
#pragma unroll
        for (int rt = 0; rt < 9; ++rt) { const int row = rt * 16 + l15; v4u p = (v4u){0u, 0u, 0u, 0u};
            if (row < 136) { const float* cp = (row < 8 ? F.c_p + row * DM : F.c_s + (row - 8) * DM) + k0; const f32x4 x0 = *(const f32x4*)cp, x1 = *(const f32x4*)(cp + 4);
                p.x = pk2(silu_f(x0[0]), silu_f(x0[1])); p.y = pk2(silu_f(x0[2]), silu_f(x0[3])); p.z = pk2(silu_f(x1[0]), silu_f(x1[1])); p.w = pk2(silu_f(x1[2]), silu_f(x1[3])); }
            const bf16x8 afr = __builtin_bit_cast(bf16x8, p);
            acc[rt][0] = MFMA16(afr, bfr[0], acc[rt][0]); acc[rt][1] = MFMA16(afr, bfr[1], acc[rt][1]); }
    }
    for (int ww = 0; ww < 8; ++ww) {
        if (w == ww) {
#pragma unroll
            for (int rt = 0; rt < 9; ++rt)
#pragma unroll
                for (int ct = 0; ct < 2; ++ct) { LAS f32x4* p = (LAS f32x4*)(red + (rt * 2 + ct) * 256 + lane * 4); if (ww == 0) *p = acc[rt][ct]; else *p = *p + acc[rt][ct]; }
        }
        __syncthreads();
    }
    for (int i = t; i < 18 * 256; i += NTHR) { const int tile = i >> 8, ln = (i >> 2) & 63, r = i & 3, rt = tile >> 1, ct = tile & 1;
        const int row = rt * 16 + (ln >> 4) * 4 + r, col = slab * 32 + ct * 16 + (ln & 15);
        if (row < 136) F.MOD[(size_t)row * MODW + col] = red[i] + F.b_ada[col]; }
    __syncthreads();
}
__device__ __forceinline__ void p0_prologue(const Frame& F, LAS unsigned char* lds) {
    const int G = gridDim.x, bx = blockIdx.x;
    LAS float* scr = (LAS float*)lds;
    for (int idx = bx * NTHR + threadIdx.x; idx < ROPE_ROWS * 64; idx += G * NTHR) { const int p = idx >> 6, j = idx & 63; const int pos = p < 2048 ? p : 16384 + (p - 2048);
        const float inv = (float)exp2(-(double)j * (13.287712379549449 / 64.0)); const float ang = (float)pos * inv;
        double rev = (double)ang * 0.15915494309189535; rev -= __builtin_rint(rev); const float fr = (float)rev;
        F.RC[idx] = __builtin_amdgcn_cosf(fr); F.RS[idx] = __builtin_amdgcn_sinf(fr); }
    for (int s = bx; s < 192; s += G) p0_mod_slab(F, s, scr);
    constexpr int N_IN = 60 * 4, N_OUT = 16 * 4, N_GU = 88 * 4, N_DN = 16 * 11;
    for (int it = (bx + G - (192 % G)) % G; it < N_IN + N_OUT + N_GU + N_DN; it += G) {
        if (it < N_IN) p0_transpose_item(F.w_in, 3600, F.WIN, DM, 0, it, scr);
        else if (it < N_IN + N_OUT) p0_transpose_item(F.w_out, DM, F.WOUT, DM, 2, it - N_IN, scr);
        else if (it < N_IN + N_OUT + N_GU) p0_transpose_item(F.w_gu, 2 * DFF, F.WGU, DM, 1, it - N_IN - N_OUT, scr);
        else p0_transpose_item(F.w_dn, DM, F.WDN, DFF, 2, it - N_IN - N_OUT - N_GU, scr);
    }
}
template <bool MODULATE> __device__ __forceinline__ void norm_phase(const float* xp, const float* xs, const float* gain, const float* mod, int shi, int sci, bf16* H, float* Y) {
    const int lane = threadIdx.x & 63, gw = blockIdx.x * 8 + (threadIdx.x >> 6), nw = gridDim.x * 8;
    f32x4 g[4];
#pragma unroll
    for (int i = 0; i < 4; ++i) g[i] = *(const f32x4*)(gain + 4 * lane + 256 * i);
    for (int row = gw; row < NTOK; row += nw) {
        const float* x = row < NTOKP ? xp + (size_t)row * DM : xs + (size_t)(row - NTOKP) * DM;
        f32x4 v[4]; float ss = 0.f;
#pragma unroll
        for (int i = 0; i < 4; ++i) { v[i] = *(const f32x4*)(x + 4 * lane + 256 * i); ss += v[i][0] * v[i][0] + v[i][1] * v[i][1] + v[i][2] * v[i][2] + v[i][3] * v[i][3]; }
        ss = wave_sum(ss);
        const float rstd = rsqrtf(ss * (1.0f / DM) + 1e-6f);
        if (MODULATE) {
            const float* m = mod + (size_t)row_seq(row) * MODW;
#pragma unroll
            for (int i = 0; i < 4; ++i) { const int c = 4 * lane + 256 * i;
                const f32x4 sc = *(const f32x4*)(m + sci * DM + c), sh = *(const f32x4*)(m + shi * DM + c);
                const f32x4 o = v[i] * rstd * g[i] * (sc + 1.0f) + sh;
                v2u w; w.x = pk2(o[0], o[1]); w.y = pk2(o[2], o[3]); *(v2u*)(H + (size_t)row * DM + c) = w; }
        } else {
#pragma unroll
            for (int i = 0; i < 4; ++i) { const int c = 4 * lane + 256 * i; *(f32x4*)(Y + (size_t)row * DM + c) = v[i] * rstd * g[i]; }
        }
    }
}
__device__ __forceinline__ void ret_pass1(const Frame& F, int item, LAS unsigned char* lds) {
    const int b = item >> 4, h = (item >> 2) & 3, s = item & 3;
    const int t = threadIdx.x, lane = t & 63, w = __builtin_amdgcn_readfirstlane(t >> 6), l15 = lane & 15, quad = lane >> 4;
    LAS bf16* Kt = (LAS bf16*)lds;
    LAS bf16* Vt = Kt + 128 * 136;
    const float lg2 = log1pf(-exp2f(-5.0f - (float)h)) * 1.4426950408889634f;
    const float gC = exp2f(lg2 * 128.0f);
    f32x4 acc[2]; acc[0] = (f32x4){0.f, 0.f, 0.f, 0.f}; acc[1] = acc[0];
    for (int n = 0; n < 16; ++n) {
        const bf16* kg = F.PROJ + (size_t)(b * 2048 + n * 128) * NPROJ + C_KR + h * 128;
        const bf16* vg = F.PROJ + (size_t)(b * 2048 + n * 128) * NPROJ + C_VR + h * 128 + s * 32;
        for (int idx = t; idx < 1024; idx += NTHR) { const int d8 = idx >> 6, jp = idx & 63;
            const v4u a = *(const v4u*)(kg + (size_t)(2 * jp) * NPROJ + d8 * 8), bb = *(const v4u*)(kg + (size_t)(2 * jp + 1) * NPROJ + d8 * 8);
            const float da = __builtin_amdgcn_exp2f(lg2 * (float)(127 - 2 * jp)), db = __builtin_amdgcn_exp2f(lg2 * (float)(126 - 2 * jp));
#pragma unroll
            for (int e = 0; e < 4; ++e) {
                *(LAS unsigned*)(Kt + (d8 * 8 + 2 * e) * 136 + 2 * jp) = pk2(bf2f(a[e] & 0xffffu) * da, bf2f(bb[e] & 0xffffu) * db);
                *(LAS unsigned*)(Kt + (d8 * 8 + 2 * e + 1) * 136 + 2 * jp) = pk2(bf2f(a[e] >> 16) * da, bf2f(bb[e] >> 16) * db);
            } }
        tile_g2l_T<128, 4>(vg, NPROJ, Vt, 136);
        { bf16* sp = F.SRET + (size_t)((b * 4 + h) * 16 + n) * 16384;
#pragma unroll
          for (int vt = 0; vt < 2; ++vt)
#pragma unroll
              for (int r = 0; r < 4; ++r) sp[(s * 32 + 16 * vt + quad * 4 + r) * 128 + 16 * w + l15] = f2bf(acc[vt][r]); }
        __syncthreads();
#pragma unroll
        for (int vt = 0; vt < 2; ++vt) { acc[vt] = acc[vt] * gC;
#pragma unroll
            for (int ks = 0; ks < 4; ++ks) acc[vt] = MFMA16(frag(Vt, 16 * vt + l15, ks * 32 + quad * 8, 136), frag(Kt, 16 * w + l15, ks * 32 + quad * 8, 136), acc[vt]); }
        __syncthreads();
    }
    float* so = F.out + O_SRP + (size_t)(b * 4 + h) * 16384;
#pragma unroll
    for (int vt = 0; vt < 2; ++vt)
#pragma unroll
        for (int r = 0; r < 4; ++r) so[(16 * w + l15) * 128 + s * 32 + 16 * vt + quad * 4 + r] = acc[vt][r];
}
__device__ __forceinline__ void gla_gk_cumsum(const Frame& F, int h, size_t row0, LAS float* bcum, LAS float* lrs, LAS float* tot) {
    const int t = threadIdx.x, dcol = t & 63, jg = t >> 6;
    if (t < 128) { const int j = t >> 1, hf = t & 1; const v4u v = *(const v4u*)(F.PROJ + (row0 + j) * NPROJ + C_LR + hf * 8);
#pragma unroll
        for (int e = 0; e < 4; ++e) { lrs[j * 16 + hf * 8 + 2 * e] = bf2f(v[e] & 0xffffu); lrs[j * 16 + hf * 8 + 2 * e + 1] = bf2f(v[e] >> 16); } }
    float w2[16];
#pragma unroll
    for (int r = 0; r < 16; ++r) w2[r] = F.w_gk[r * 256 + h * 64 + dcol];
    const float bias = F.b_gk[h * 64 + dcol];
    __syncthreads();
    float gl[8]; float run = 0.f;
#pragma unroll
    for (int i = 0; i < 8; ++i) { float z = bias;
#pragma unroll
        for (int r4 = 0; r4 < 4; ++r4) { const f32x4 l = *(const LAS f32x4*)(lrs + (jg * 8 + i) * 16 + r4 * 4); z += l[0] * w2[r4 * 4] + l[1] * w2[r4 * 4 + 1] + l[2] * w2[r4 * 4 + 2] + l[3] * w2[r4 * 4 + 3]; }
        run += logsig16(z); gl[i] = run; }
    tot[jg * 64 + dcol] = run;
    __syncthreads();
    float pre = 0.f;
#pragma unroll
    for (int q = 0; q < 8; ++q) { const float v = tot[q * 64 + dcol]; pre += (q < jg) ? v : 0.f; }
#pragma unroll
    for (int i = 0; i < 8; ++i) bcum[(jg * 8 + i) * 64 + dcol] = pre + gl[i];
    __syncthreads();
}
__device__ __forceinline__ void gla_pass1(const Frame& F, int item, LAS unsigned char* lds) {
    const int b = item >> 4, h = (item >> 2) & 3, s = item & 3;
    const int t = threadIdx.x, lane = t & 63, w = __builtin_amdgcn_readfirstlane(t >> 6), l15 = lane & 15, quad = lane >> 4;
    LAS bf16* Kt = (LAS bf16*)lds;
    LAS bf16* Vt = Kt + 64 * 72;
    LAS float* bcum = (LAS float*)(lds + 16384);
    LAS float* lrs = bcum + 4096;
    LAS float* tot = lrs + 1024;
    const int vt = w >> 2, dt = w & 3;
    f32x4 acc = (f32x4){0.f, 0.f, 0.f, 0.f};
    for (int n = 0; n < 32; ++n) {
        const size_t row0 = (size_t)b * 2048 + n * 64;
        gla_gk_cumsum(F, h, row0, bcum, lrs, tot);
        if (t < 256) { const int d8 = t >> 5, jp = t & 31;
            const bf16* kg = F.PROJ + row0 * NPROJ + C_KG + h * 64 + d8 * 8;
            const v4u a = *(const v4u*)(kg + (size_t)(2 * jp) * NPROJ), bb = *(const v4u*)(kg + (size_t)(2 * jp + 1) * NPROJ);
#pragma unroll
            for (int e = 0; e < 4; ++e) {
                const int d0 = d8 * 8 + 2 * e;
                const float bl0 = bcum[63 * 64 + d0], bl1 = bcum[63 * 64 + d0 + 1];
                const float ea0 = __expf(bl0 - bcum[(2 * jp) * 64 + d0]), eb0 = __expf(bl0 - bcum[(2 * jp + 1) * 64 + d0]);
                const float ea1 = __expf(bl1 - bcum[(2 * jp) * 64 + d0 + 1]), eb1 = __expf(bl1 - bcum[(2 * jp + 1) * 64 + d0 + 1]);
                *(LAS unsigned*)(Kt + d0 * 72 + 2 * jp) = pk2(bf2f(a[e] & 0xffffu) * ea0, bf2f(bb[e] & 0xffffu) * eb0);
                *(LAS unsigned*)(Kt + (d0 + 1) * 72 + 2 * jp) = pk2(bf2f(a[e] >> 16) * ea1, bf2f(bb[e] >> 16) * eb1);
            } }
        else if (t < 384) { const int u = t - 256, v8 = u >> 5, jp = u & 31;
            const bf16* vg = F.PROJ + row0 * NPROJ + C_VG + h * 128 + s * 32 + v8 * 8;
            const v4u a = *(const v4u*)(vg + (size_t)(2 * jp) * NPROJ), bb = *(const v4u*)(vg + (size_t)(2 * jp + 1) * NPROJ);
#pragma unroll
            for (int e = 0; e < 4; ++e) {
                *(LAS unsigned*)(Vt + (v8 * 8 + 2 * e) * 72 + 2 * jp) = (a[e] & 0xffffu) | (bb[e] << 16);
                *(LAS unsigned*)(Vt + (v8 * 8 + 2 * e + 1) * 72 + 2 * jp) = (a[e] >> 16) | (bb[e] & 0xffff0000u);
            } }
        { bf16* sp = F.SGLA + (size_t)((b * 4 + h) * 32 + n) * 8192;
#pragma unroll
          for (int r = 0; r < 4; ++r) sp[(s * 32 + 16 * vt + quad * 4 + r) * 64 + 16 * dt + l15] = f2bf(acc[r]); }
        __syncthreads();
        acc = acc * __expf(bcum[63 * 64 + 16 * dt + l15]);
#pragma unroll
        for (int ks = 0; ks < 2; ++ks) acc = MFMA16(frag(Vt, 16 * vt + l15, ks * 32 + quad * 8, 72), frag(Kt, 16 * dt + l15, ks * 32 + quad * 8, 72), acc);
    }
    float* so = F.out + O_SGP + (size_t)(b * 4 + h) * 8192;
#pragma unroll
    for (int r = 0; r < 4; ++r) so[(16 * dt + l15) * 128 + s * 32 + 16 * vt + quad * 4 + r] = acc[r];
    __syncthreads();
}
template <int DK, bool GLA> __device__ __forceinline__ void sample_item(const Frame& F, int bs, int h, LAS unsigned char* lds) {
    const int t = threadIdx.x, lane = t & 63, w = t >> 6;
    LAS float* qs = (LAS float*)lds;
    LAS float* ks = qs + 8 * DK;
    LAS float* dc = ks + 8 * DK;
    LAS float* vs = dc + 8 * DK;
    LAS float* part = vs + 8 * 128;
    LAS float* lrs = part + 4 * 8 * 128;
    const size_t row0 = (size_t)NTOKP + bs * 8;
    const int qcol = GLA ? C_QG + h * 64 : C_QR + h * 128, kcol = GLA ? C_KG + h * 64 : C_KR + h * 128;
    const int vcol = GLA ? C_VG + h * 128 : C_VR + h * 128, gcol = GLA ? C_GG + h * 128 : C_GR + h * 128;
    for (int idx = t; idx < 8 * DK; idx += NTHR) { const int tok = idx / DK, d = idx % DK;
        qs[idx] = bf2f(F.PROJ[(row0 + tok) * NPROJ + qcol + d]); ks[idx] = bf2f(F.PROJ[(row0 + tok) * NPROJ + kcol + d]); }
    for (int idx = t; idx < 8 * 128; idx += NTHR) { const int tok = idx >> 7, v = idx & 127; vs[idx] = bf2f(F.PROJ[(row0 + tok) * NPROJ + vcol + v]); }
    if (GLA) { if (t < 128) lrs[t] = bf2f(F.PROJ[(row0 + (t >> 4)) * NPROJ + C_LR + (t & 15)]); }
    __syncthreads();
    if (GLA) { const int tok = t >> 6, d = t & 63; float z = F.b_gk[h * 64 + d];
#pragma unroll
        for (int r = 0; r < 16; ++r) z += lrs[tok * 16 + r] * F.w_gk[r * 256 + h * 64 + d];
        dc[t] = __expf(logsig16(z));
        __syncthreads(); }
    constexpr int DPT = DK / 4;
    const int v = t & 127, dq = t >> 7, d0 = dq * DPT;
    const float* S0 = (GLA ? F.st_gla : F.st_ret) + (size_t)(bs * 4 + h) * DK * 128;
    float* So = F.out + (GLA ? O_SGS : O_SRS) + (size_t)(bs * 4 + h) * DK * 128;
    float S[DPT];
#pragma unroll
    for (int i = 0; i < DPT; ++i) S[i] = S0[(d0 + i) * 128 + v];
    const float gam = 1.0f - exp2f(-5.0f - (float)h);
#pragma unroll
    for (int tok = 0; tok < 8; ++tok) { const float vv = vs[tok * 128 + v]; float po = 0.f;
#pragma unroll
        for (int i4 = 0; i4 < DPT; i4 += 4) {
            const f32x4 kk = *(const LAS f32x4*)(ks + tok * DK + d0 + i4), qq = *(const LAS f32x4*)(qs + tok * DK + d0 + i4);
            f32x4 dd = (f32x4){gam, gam, gam, gam}; if (GLA) dd = *(const LAS f32x4*)(dc + tok * DK + d0 + i4);
#pragma unroll
            for (int e = 0; e < 4; ++e) { S[i4 + e] = dd[e] * S[i4 + e] + kk[e] * vv; po += qq[e] * S[i4 + e]; } }
        part[(dq * 8 + tok) * 128 + v] = po; }
#pragma unroll
    for (int i = 0; i < DPT; ++i) So[(d0 + i) * 128 + v] = S[i];
    __syncthreads();
    { const int tok = w; const size_t row = row0 + tok; const float* gain = (GLA ? F.gla_norm : F.ret_norm) + h * 128;
      float o[2];
#pragma unroll
      for (int q = 0; q < 2; ++q) { const int vv = lane + 64 * q; o[q] = part[(0 * 8 + tok) * 128 + vv] + part[(1 * 8 + tok) * 128 + vv] + part[(2 * 8 + tok) * 128 + vv] + part[(3 * 8 + tok) * 128 + vv]; }
      const float ss = wave_sum(o[0] * o[0] + o[1] * o[1]);
      const float rstd = rsqrtf(ss * (1.0f / 128.0f) + 1e-6f);
#pragma unroll
      for (int q = 0; q < 2; ++q) { const int vv = lane + 64 * q; const float g = bf2f(F.PROJ[row * NPROJ + gcol + vv]);
          F.MIX[row * DM + (GLA ? 512 : 0) + h * 128 + vv] = f2bf(o[q] * rstd * gain[vv] * silu_f(g)); } }
    __syncthreads();
}
__device__ __forceinline__ void ret_pass2(const Frame& F, int item, LAS unsigned char* lds) {
    const int b = item >> 6, h = (item >> 4) & 3, n = item & 15;
    const int t = threadIdx.x, lane = t & 63, w = __builtin_amdgcn_readfirstlane(t >> 6), l15 = lane & 15, quad = lane >> 4;
    LAS bf16* Qs = (LAS bf16*)lds; LAS bf16* Ks = Qs + 128 * 136; LAS bf16* Vt = Ks + 128 * 136; LAS bf16* St = Vt + 128 * 136;
    const size_t row0 = (size_t)b * 2048 + n * 128;
    tile_g2l<128, 16>(F.PROJ + row0 * NPROJ + C_QR + h * 128, NPROJ, Qs, 136);
    tile_g2l<128, 16>(F.PROJ + row0 * NPROJ + C_KR + h * 128, NPROJ, Ks, 136);
    tile_g2l<128, 16>(F.SRET + (size_t)((b * 4 + h) * 16 + n) * 16384, 128, St, 136);
    tile_g2l_T<128, 16>(F.PROJ + row0 * NPROJ + C_VR + h * 128, NPROJ, Vt, 136);
    __syncthreads();
    const float lg2 = log1pf(-exp2f(-5.0f - (float)h)) * 1.4426950408889634f;
    const int i0 = 16 * w;
    bf16x8 qa[4];
#pragma unroll
    for (int ks = 0; ks < 4; ++ks) qa[ks] = frag(Qs, i0 + l15, ks * 32 + quad * 8, 136);
    f32x4 acc[8];
#pragma unroll
    for (int vt = 0; vt < 8; ++vt) { acc[vt] = (f32x4){0.f, 0.f, 0.f, 0.f};
#pragma unroll
        for (int ks = 0; ks < 4; ++ks) acc[vt] = MFMA16(qa[ks], frag(St, 16 * vt + l15, ks * 32 + quad * 8, 136), acc[vt]); }
    { f32x4 sc;
#pragma unroll
      for (int r = 0; r < 4; ++r) sc[r] = __builtin_amdgcn_exp2f(lg2 * (float)(i0 + quad * 4 + r + 1));
#pragma unroll
      for (int vt = 0; vt < 8; ++vt) acc[vt] = acc[vt] * sc; }
    LAS bf16* At = Qs + i0 * 136;
    asm volatile("s_waitcnt lgkmcnt(0)" ::: "memory");
    const int njt = (w | 1) + 1;
    for (int jt = 0; jt < njt; ++jt) {
        f32x4 sv = (f32x4){0.f, 0.f, 0.f, 0.f};
        if (jt <= w) {
#pragma unroll
            for (int ks = 0; ks < 4; ++ks) sv = MFMA16(qa[ks], frag(Ks, 16 * jt + l15, ks * 32 + quad * 8, 136), sv); }
#pragma unroll
        for (int r = 0; r < 4; ++r) { const int diff = (i0 + quad * 4 + r) - (16 * jt + l15);
            const float val = diff >= 0 ? sv[r] * __builtin_amdgcn_exp2f(lg2 * (float)diff) : 0.f;
            At[(quad * 4 + r) * 136 + 16 * jt + l15] = f2bf(val); }
    }
    asm volatile("s_waitcnt lgkmcnt(0)" ::: "memory");
    const int nks = (w >> 1) + 1;
    for (int ks = 0; ks < nks; ++ks) { const bf16x8 aa = frag(At, l15, ks * 32 + quad * 8, 136);
#pragma unroll
        for (int vt = 0; vt < 8; ++vt) acc[vt] = MFMA16(aa, frag(Vt, 16 * vt + l15, ks * 32 + quad * 8, 136), acc[vt]); }
    f32x4 ss = (f32x4){0.f, 0.f, 0.f, 0.f};
#pragma unroll
    for (int vt = 0; vt < 8; ++vt) ss += acc[vt] * acc[vt];
#pragma unroll
    for (int r = 0; r < 4; ++r) { float v = ss[r]; v += __shfl_xor(v, 1); v += __shfl_xor(v, 2); v += __shfl_xor(v, 4); v += __shfl_xor(v, 8); ss[r] = rsqrtf(v * (1.0f / 128.0f) + 1e-6f); }
#pragma unroll
    for (int vt = 0; vt < 8; ++vt) { const int col = h * 128 + 16 * vt + l15; const float gn = F.ret_norm[col];
#pragma unroll
        for (int r = 0; r < 4; ++r) { const size_t row = row0 + i0 + quad * 4 + r; const float g = bf2f(F.PROJ[row * NPROJ + C_GR + col]);
            F.MIX[row * DM + col] = f2bf(acc[vt][r] * ss[r] * gn * silu_f(g)); } }
    __syncthreads();
}
__device__ __forceinline__ void gla_pass2(const Frame& F, int item, LAS unsigned char* lds) {
    const int b = item >> 7, h = (item >> 5) & 3, n = item & 31;
    const int t = threadIdx.x, lane = t & 63, w = __builtin_amdgcn_readfirstlane(t >> 6), l15 = lane & 15, quad = lane >> 4;
    LAS bf16* Qs = (LAS bf16*)lds;
    LAS bf16* Ks = Qs + 64 * 72;
    LAS bf16* Vt = Ks + 64 * 72;
    LAS bf16* St = Vt + 128 * 72;
    LAS bf16* Aw = St + 128 * 72;
    LAS float* bcum = (LAS float*)(lds + 73728);
    LAS float* lrs = bcum + 4096;
    LAS float* tot = lrs + 1024;
    LAS float* ssx = tot + 512;
    const size_t row0 = (size_t)b * 2048 + n * 64;
    tile_g2l_T<64, 16>(F.PROJ + row0 * NPROJ + C_VG + h * 128, NPROJ, Vt, 72);
    tile_g2l<128, 8>(F.SGLA + (size_t)((b * 4 + h) * 32 + n) * 8192, 64, St, 72);
    gla_gk_cumsum(F, h, row0, bcum, lrs, tot);
    { const int i = t >> 3, d8 = (t & 7) * 8;
      const v4u q = *(const v4u*)(F.PROJ + (row0 + i) * NPROJ + C_QG + h * 64 + d8), k = *(const v4u*)(F.PROJ + (row0 + i) * NPROJ + C_KG + h * 64 + d8);
      const f32x4 b0 = *(const LAS f32x4*)(bcum + i * 64 + d8), b1 = *(const LAS f32x4*)(bcum + i * 64 + d8 + 4);
      v4u qo, ko;
#pragma unroll
      for (int e = 0; e < 4; ++e) { const float ba = e < 2 ? b0[2 * e] : b1[2 * e - 4], bb = e < 2 ? b0[2 * e + 1] : b1[2 * e - 3];
          const float ea = __expf(ba), eb = __expf(bb);
          qo[e] = pk2(bf2f(q[e] & 0xffffu) * ea, bf2f(q[e] >> 16) * eb);
          ko[e] = pk2(bf2f(k[e] & 0xffffu) * __builtin_amdgcn_rcpf(ea), bf2f(k[e] >> 16) * __builtin_amdgcn_rcpf(eb)); }
      *(LAS v4u*)(Qs + i * 72 + d8) = qo; *(LAS v4u*)(Ks + i * 72 + d8) = ko; }
    __syncthreads();
    const int rt = w & 3, vh = w >> 2, i0 = 16 * rt;
    bf16x8 qa[2];
#pragma unroll
    for (int ks = 0; ks < 2; ++ks) qa[ks] = frag(Qs, i0 + l15, ks * 32 + quad * 8, 72);
    f32x4 acc[4];
#pragma unroll
    for (int v4 = 0; v4 < 4; ++v4) { acc[v4] = (f32x4){0.f, 0.f, 0.f, 0.f};
#pragma unroll
        for (int ks = 0; ks < 2; ++ks) acc[v4] = MFMA16(qa[ks], frag(St, 16 * (vh * 4 + v4) + l15, ks * 32 + quad * 8, 72), acc[v4]); }
    LAS bf16* At = Aw + w * 16 * 72;
    const int njt = (rt | 1) + 1;
    for (int jt = 0; jt < njt; ++jt) {
        f32x4 sv = (f32x4){0.f, 0.f, 0.f, 0.f};
        if (jt <= rt) {
#pragma unroll
            for (int ks = 0; ks < 2; ++ks) sv = MFMA16(qa[ks], frag(Ks, 16 * jt + l15, ks * 32 + quad * 8, 72), sv); }
#pragma unroll
        for (int r = 0; r < 4; ++r) { const int diff = (i0 + quad * 4 + r) - (16 * jt + l15);
            At[(quad * 4 + r) * 72 + 16 * jt + l15] = f2bf(diff >= 0 ? sv[r] : 0.f); }
    }
    asm volatile("s_waitcnt lgkmcnt(0)" ::: "memory");
    const int nks = (rt >> 1) + 1;
    for (int ks = 0; ks < nks; ++ks) { const bf16x8 aa = frag(At, l15, ks * 32 + quad * 8, 72);
#pragma unroll
        for (int v4 = 0; v4 < 4; ++v4) acc[v4] = MFMA16(aa, frag(Vt, 16 * (vh * 4 + v4) + l15, ks * 32 + quad * 8, 72), acc[v4]); }
    f32x4 ss = (f32x4){0.f, 0.f, 0.f, 0.f};
#pragma unroll
    for (int v4 = 0; v4 < 4; ++v4) ss += acc[v4] * acc[v4];
#pragma unroll
    for (int r = 0; r < 4; ++r) { float v = ss[r]; v += __shfl_xor(v, 1); v += __shfl_xor(v, 2); v += __shfl_xor(v, 4); v += __shfl_xor(v, 8); ss[r] = v; }
    if (l15 == 0) { ssx[w * 16 + quad * 4 + 0] = ss[0]; ssx[w * 16 + quad * 4 + 1] = ss[1]; ssx[w * 16 + quad * 4 + 2] = ss[2]; ssx[w * 16 + quad * 4 + 3] = ss[3]; }
    __syncthreads();
#pragma unroll
    for (int r = 0; r < 4; ++r) ss[r] = rsqrtf((ssx[w * 16 + quad * 4 + r] + ssx[(w ^ 4) * 16 + quad * 4 + r]) * (1.0f / 128.0f) + 1e-6f);
#pragma unroll
    for (int v4 = 0; v4 < 4; ++v4) { const int hv = h * 128 + 16 * (vh * 4 + v4) + l15; const float gn = F.gla_norm[hv];
#pragma unroll
        for (int r = 0; r < 4; ++r) { const size_t row = row0 + i0 + quad * 4 + r; const float g = bf2f(F.PROJ[row * NPROJ + C_GG + hv]);
            F.MIX[row * DM + 512 + hv] = f2bf(acc[v4][r] * ss[r] * gn * silu_f(g)); } }
    __syncthreads();
}
#define XB_TMO      128
#define XB_XCNT(j)  (256  + 64 * (j))
#define XB_XSUB(j)  (1280 + 64 * (j))
#define XB_XGEN(j)  (2304 + 64 * (j))
#define XB_TOP      3328
#define XB_TOPGEN   3392
#define XCD_BAR_WORDS 3456
#define XB_SPIN_CAP (1u << 18)

__device__ __forceinline__ unsigned xb_ld(unsigned* p)              { return __hip_atomic_load(p, __ATOMIC_RELAXED, __HIP_MEMORY_SCOPE_AGENT); }
__device__ __forceinline__ unsigned xb_add(unsigned* p, unsigned v) { return __hip_atomic_fetch_add(p, v, __ATOMIC_RELAXED, __HIP_MEMORY_SCOPE_AGENT); }
__device__ __forceinline__ unsigned xb_xcc_id() { return (unsigned)__builtin_amdgcn_s_getreg((3 << 11) | 20) & 0xFu; }
#define XB_SPIN(cond, bar) do { unsigned _sp = 0; while (cond) { __builtin_amdgcn_s_sleep(1); \
    if ((++_sp & 255u) == 0u) { if (xb_ld(&(bar)[XB_TMO])) break; if (_sp > XB_SPIN_CAP) { atomicAdd(&(bar)[XB_TMO], 1u); break; } } } } while (0)

struct XcdBarrier {
    unsigned* bar; unsigned x;
    volatile LAS unsigned* st;
};

__device__ __forceinline__ XcdBarrier xcd_barrier_post(unsigned* bar, volatile LAS unsigned* st) {
    XcdBarrier b; b.bar = bar; b.x = xb_xcc_id(); b.st = st;
    if (threadIdx.x == 0) (void)xb_add(&bar[XB_XCNT(b.x)], 1u);
    return b;
}
__device__ __forceinline__ void xcd_barrier_complete(unsigned* bar, unsigned x, unsigned& nloc, unsigned& nx) {
    const unsigned G = gridDim.x * gridDim.y * gridDim.z;
    unsigned sum, cnt, mine, sp = 0u;
    for (;;) {
        sum = 0u; cnt = 0u; mine = 0u;
#pragma unroll
        for (unsigned j = 0; j < 16; ++j) { const unsigned c = xb_ld(&bar[XB_XCNT(j)]); sum += c; cnt += (c > 0u) ? 1u : 0u; mine = (j == x) ? c : mine; }
        if (sum == G) break;
        __builtin_amdgcn_s_sleep(1);
        if ((++sp & 255u) == 0u) { if (xb_ld(&bar[XB_TMO])) break; if (sp > XB_SPIN_CAP) { atomicAdd(&bar[XB_TMO], 1u); break; } }
    }
    nloc = mine > 0u ? mine : 1u; nx = cnt > 0u ? cnt : 1u;
}

__device__ __forceinline__ void xcd_barrier(const XcdBarrier& b) {
    asm volatile("s_waitcnt vmcnt(0)" ::: "memory");
    __syncthreads();
    if (threadIdx.x == 0) {
        unsigned* bar = b.bar;
        __builtin_amdgcn_s_waitcnt(0);
        unsigned nloc = b.st[0], nx = b.st[1];
        if (nloc == 0u) { xcd_barrier_complete(bar, b.x, nloc, nx); b.st[0] = nloc; b.st[1] = nx; }
        const unsigned old = xb_add(&bar[XB_XSUB(b.x)], 1u);
        const unsigned gen = old / nloc;
        if (old + 1u == (gen + 1u) * nloc) {
            __builtin_amdgcn_fence(__ATOMIC_RELEASE, "agent");
            asm volatile("s_waitcnt vmcnt(0)" ::: "memory");
            const unsigned og = xb_add(&bar[XB_TOP], 1u);
            const unsigned tg = og / nx;
            if (og + 1u == (tg + 1u) * nx) xb_add(&bar[XB_TOPGEN], 1u);
            else XB_SPIN(xb_ld(&bar[XB_TOPGEN]) == tg, bar);
            __builtin_amdgcn_fence(__ATOMIC_ACQUIRE, "agent");
            xb_add(&bar[XB_XGEN(b.x)], 1u);
            asm volatile("s_waitcnt vmcnt(0)" ::: "memory");
        } else {
            XB_SPIN(xb_ld(&bar[XB_XGEN(b.x)]) == gen, bar);
            __builtin_amdgcn_fence(__ATOMIC_ACQUIRE, "agent");
            asm volatile("s_waitcnt vmcnt(0)" ::: "memory");
        }
    }
    __syncthreads();
}
#ifndef MK_N_LAUNCHES
#define MK_N_LAUNCHES 1
#endif
constexpr int N_PHASES = 10;
#ifndef PROBE_PH
#define PROBE_PH (-1)
#define PROBE_REPS 1
#endif
struct Args { const float* in[19]; float* out; unsigned char* ws; int ph_lo, ph_hi; };
__global__ void __launch_bounds__(NTHR, 2) hybrid_fwd(Args a) {
    extern __shared__ __attribute__((aligned(16))) unsigned char lds_raw[];
    LAS unsigned char* lds = (LAS unsigned char*)lds_raw;
    cg::grid_group grid = cg::this_grid();
    if (a.ph_lo < 0) grid.sync();
    volatile LAS unsigned* misc = (volatile LAS unsigned*)(lds + LDS_BYTES - 64);
    if (threadIdx.x < 2) misc[threadIdx.x] = 0u;
    __syncthreads();
    XcdBarrier bar = xcd_barrier_post((unsigned*)a.ws, misc);
    Frame F;
    F.x_p = a.in[0]; F.x_s = a.in[1]; F.st_ret = a.in[2]; F.st_gla = a.in[3]; F.c_p = a.in[4]; F.c_s = a.in[5]; F.w_ada = a.in[6]; F.b_ada = a.in[7]; F.mix_norm = a.in[8];
    F.w_in = a.in[9]; F.w_gk = a.in[10]; F.b_gk = a.in[11]; F.ret_norm = a.in[12]; F.gla_norm = a.in[13]; F.w_out = a.in[14]; F.ffn_norm = a.in[15]; F.w_gu = a.in[16];
    F.w_dn = a.in[17]; F.fin_norm = a.in[18]; F.out = a.out; F.ws = a.ws;
    F.WIN = (bf16*)(a.ws + WS_WIN); F.WOUT = (bf16*)(a.ws + WS_WOUT); F.WGU = (bf16*)(a.ws + WS_WGU); F.WDN = (bf16*)(a.ws + WS_WDN);
    F.H = (bf16*)(a.ws + WS_H); F.MIX = (bf16*)(a.ws + WS_MIX); F.PROJ = (bf16*)(a.ws + WS_PROJ); F.HID = (bf16*)(a.ws + WS_HID);
    F.SRET = (bf16*)(a.ws + WS_SRET); F.SGLA = (bf16*)(a.ws + WS_SGLA);
    F.MOD = (float*)(a.ws + WS_MOD); F.RC = (float*)(a.ws + WS_ROPE); F.RS = F.RC + ROPE_ROWS * 64;
    const int G = gridDim.x, bx = blockIdx.x, lo = a.ph_lo, hi = a.ph_hi;
#define IN(k) (lo <= (k) && (k) < hi)
#define SEAM(k) do { if (IN(k) && IN((k) + 1)) xcd_barrier(bar); } while (0)
#define RUN(k, BODY) do { if (IN(k)) { for (int rep = 0; rep < ((PROBE_PH == (k)) ? PROBE_REPS : 1); ++rep) { if (rep) xcd_barrier(bar); BODY; } } SEAM(k); } while (0)
#define PH0 p0_prologue(F, lds)
#define PH1 norm_phase<true>(F.x_p, F.x_s, F.mix_norm, F.MOD, 0, 1, F.H, nullptr)
#define PH2 { pg8::Gemm g{F.H, F.WIN, NTOK, NPROJ, DM}; pg8::StaticOrder S; S.init(NTOK, NPROJ, G, bx); pg8::EpiProj E{F.PROJ, F.RC, F.RS}; \
        pg8::gemm_phase<pg8::EpiProj, pg8::StaticOrder, true, true>(lds, g, S, E); }
#define PH3 { for (int it = bx; it < 256; it += G) { if (it < 128) ret_pass1(F, it, lds); else gla_pass1(F, it - 128, lds); } \
        for (int j = bx; j < 1024; j += G) { if (j < 512) sample_item<128, false>(F, j >> 2, j & 3, lds); else sample_item<64, true>(F, (j - 512) >> 2, j & 3, lds); } }
#define PH4 { for (int it = bx; it < 1536; it += G) { if (it < 512) ret_pass2(F, it, lds); else gla_pass2(F, it - 512, lds); } }
#define PH5 { pg8::Gemm g{F.MIX, F.WOUT, NTOK, DM, DM}; pg8::StaticOrder S; S.init(NTOK, DM, G, bx); pg8::EpiRes E{F.x_p, F.x_s, F.out, F.MOD + 2 * DM}; \
        pg8::gemm_phase<pg8::EpiRes, pg8::StaticOrder, true, true>(lds, g, S, E); }
#define PH6 norm_phase<true>(F.out, F.out + (size_t)NTOKP * DM, F.ffn_norm, F.MOD, 3, 4, F.H, nullptr)
#define PH7 { pg8::Gemm g{F.H, F.WGU, NTOK, 2 * DFF, DM}; pg8::StaticOrder S; S.init(NTOK, 2 * DFF, G, bx); pg8::EpiSwiGLU E{F.HID}; \
        pg8::gemm_phase<pg8::EpiSwiGLU, pg8::StaticOrder, true, true>(lds, g, S, E); }
#define PH8 { pg8::Gemm g{F.HID, F.WDN, NTOK, DM, DFF}; pg8::StaticOrder S; S.init(NTOK, DM, G, bx); pg8::EpiRes E{F.out, F.out + (size_t)NTOKP * DM, F.out, F.MOD + 5 * DM}; \
        pg8::gemm_phase<pg8::EpiRes, pg8::StaticOrder, true, true>(lds, g, S, E); }
#define PH9 norm_phase<false>(F.out, F.out + (size_t)NTOKP * DM, F.fin_norm, nullptr, 0, 0, nullptr, F.out)
    RUN(0, PH0); RUN(1, PH1);
#ifdef PROBE_SYNCS
    for (int i = 0; i < PROBE_SYNCS; ++i) xcd_barrier(bar);
#endif
    RUN(2, PH2); RUN(3, PH3); RUN(4, PH4); RUN(5, PH5); RUN(6, PH6); RUN(7, PH7); RUN(8, PH8); RUN(9, PH9);
}

extern "C" void kernel_launch(void* const* d_in, const int* in_sizes, int n_in, void* d_out, int out_size, void* d_ws, size_t ws_size, hipStream_t stream) {
    static int grid = 0;
    if (grid == 0) {
        int dev = 0, cus = 0, per_cu = 0;
        if (n_in != 19 || ws_size < WS_END) { fprintf(stderr, "kernel_launch: unexpected n_in %d / ws %zu\n", n_in, ws_size); grid = -1; return; }
        (void)hipGetDevice(&dev);
        (void)hipDeviceGetAttribute(&cus, hipDeviceAttributeMultiprocessorCount, dev);
        (void)hipFuncSetAttribute((const void*)hybrid_fwd, hipFuncAttributeMaxDynamicSharedMemorySize, LDS_BYTES);
        (void)hipOccupancyMaxActiveBlocksPerMultiprocessor(&per_cu, (const void*)hybrid_fwd, NTHR, LDS_BYTES);
        if (per_cu < 1) { fprintf(stderr, "kernel_launch: occupancy query reports %d blocks per CU\n", per_cu); grid = -1; return; }
        grid = cus;
        if (grid > 256) grid = 256;
    }
    if (grid < 0) return;
    (void)hipMemsetAsync(d_ws, 0, XCD_BAR_WORDS * 4, stream);
    Args a{};
    for (int i = 0; i < 19; ++i) a.in[i] = (const float*)d_in[i];
    a.out = (float*)d_out; a.ws = (unsigned char*)d_ws;
#if MK_N_LAUNCHES == 1
    a.ph_lo = 0; a.ph_hi = N_PHASES;
    void* args[] = {&a};
    hipError_t e = hipLaunchCooperativeKernel((void*)hybrid_fwd, dim3(grid), dim3(NTHR), args, LDS_BYTES, stream);
    if (e != hipSuccess) fprintf(stderr, "cooperative launch failed: %s (grid %d)\n", hipGetErrorString(e), grid);
#else
    for (int p = 0; p < N_PHASES; ++p) { a.ph_lo = p; a.ph_hi = p + 1; hipLaunchKernelGGL(hybrid_fwd, dim3(grid), dim3(NTHR), LDS_BYTES, stream, a); }
#endif
}
```

```cpp
#include <hip/hip_runtime.h>
#include <hip/hip_cooperative_groups.h>
#include <cstdio>
#include <cstdint>
namespace cg = cooperative_groups;

constexpr int NTOKP = 16384, NTOK = 17408, DM = 1024, NPROJ = 3840, DFF = 2816, MODW = 6144;
__device__ __forceinline__ int row_seq(int row) { return row < NTOKP ? (row >> 11) : 8 + ((row - NTOKP) >> 3); }
__device__ __forceinline__ int row_rope(int row) { return row < NTOKP ? (row & 2047) : 2048 + ((row - NTOKP) & 7); }
namespace pg8 {
#define PG8_LAS __attribute__((address_space(3)))
typedef unsigned short bf16_t;
typedef short bf16x8 __attribute__((ext_vector_type(8)));
typedef float f32x4 __attribute__((ext_vector_type(4)));
typedef unsigned u32x4 __attribute__((ext_vector_type(4)));
constexpr int BM = 256, BK = 64, HALF = 128, HTB = HALF * BK * 2  , STAGE_BYTES = 8 * HTB, NXCD = 8, WGM = 8;

__host__ __device__ __forceinline__ int lds_byte(int r, int c) { const int st = (r >> 4) * 2 + (c >> 5), rr = r & 15, cc = c & 31, ob = rr * 64 + cc * 2; return st * 1024 + (ob ^ (((ob >> 9) & 1) << 5)); }
__host__ __device__ __forceinline__ void stage_rc(int b, int& R, int& C) { const int st = b / 1024, sb = b % 1024, swz = sb ^ (((sb >> 9) & 1) << 5); R = (st >> 1) * 16 + swz / 64; C = (st & 1) * 32 + (swz % 64) / 2; }
__host__ __device__ __forceinline__ int perm32(int rho) { const int n = rho >> 4, i = rho & 15; return 8 * (i >> 2) + 4 * n + (i & 3); }

struct Unit { int pm, pn, k0, nt; };
struct Gemm { const bf16_t* A; const bf16_t* Bt; int M, N, K; };

struct StaticOrder {
    int nM, nN, nwg, G, c, ntk;
    __host__ __device__ void init(int M, int N, int G_, int c_, int K_) { nM = M / BM; nN = N / BM; nwg = nM * nN; G = G_; c = c_; ntk = K_ / BK; }
    __host__ __device__ bool next(int i, Unit& u) const {
        const long L = (long)i * G + c; if (L >= nwg) return false;
        int wgid = (int)L; { const int q = nwg / NXCD, r = nwg % NXCD, xcd = wgid % NXCD, off = wgid / NXCD; wgid = (xcd < r ? xcd * (q + 1) : r * (q + 1) + (xcd - r) * q) + off; }
        const int nig = WGM * nN, gid = wgid / nig, fm = gid * WGM, gsz = (nM - fm) < WGM ? (nM - fm) : WGM;
        u.pm = fm + ((wgid % nig) % gsz); u.pn = (wgid % nig) / gsz; u.k0 = 0; u.nt = ntk; return true;
    }
    __device__ __forceinline__ void a_ready(const Unit&) const {}
    __device__ __forceinline__ void done(const Unit&) const {}
};

__device__ __forceinline__ unsigned cvt_pk_bf16(float lo, float hi) { unsigned r; asm volatile("v_cvt_pk_bf16_f32 %0, %1, %2" : "=v"(r) : "v"(lo), "v"(hi)); return r; }
struct EpiProj {
    static constexpr bool PERM = true, AFTER_DRAIN = false;
    bf16_t* O; const float* cs; const float* sn;
    __device__ __forceinline__ void operator()(const f32x4 (&acc)[2][2][4][2], const Unit& u, int wr, int wc, int fr, int fq) const {
        const int row0 = u.pm * BM + wr * 64 + fr;
        if (u.pn < 4) {
            const int hl = wc >> 1, f0 = 32 * (wc & 1) + 8 * fq;
            const float scale = (u.pn >= 2) ? 0.08838834764831845f : 1.0f;
            const int colbase = u.pn * 256 + hl * 128 + f0;
#pragma unroll
            for (int ai = 0; ai < 2; ++ai)
#pragma unroll
                for (int m = 0; m < 4; ++m) {
                    const int row = row0 + ai * HALF + m * 16; const int pr = row_rope(row);
                    const f32x4 c0 = *(const f32x4*)(cs + pr * 64 + f0), c1 = *(const f32x4*)(cs + pr * 64 + f0 + 4);
                    const f32x4 s0 = *(const f32x4*)(sn + pr * 64 + f0), s1 = *(const f32x4*)(sn + pr * 64 + f0 + 4);
                    const f32x4 x10 = acc[ai][0][m][0], x11 = acc[ai][0][m][1], x20 = acc[ai][1][m][0], x21 = acc[ai][1][m][1];
                    const f32x4 a0 = (x10 * c0 - x20 * s0) * scale, a1 = (x11 * c1 - x21 * s1) * scale;
                    const f32x4 b0 = (x10 * s0 + x20 * c0) * scale, b1 = (x11 * s1 + x21 * c1) * scale;
                    bf16_t* rowp = O + (size_t)row * NPROJ + colbase;
                    u32x4 w; w.x = cvt_pk_bf16(a0[0], a0[1]); w.y = cvt_pk_bf16(a0[2], a0[3]); w.z = cvt_pk_bf16(a1[0], a1[1]); w.w = cvt_pk_bf16(a1[2], a1[3]);
                    *(u32x4*)rowp = w;
                    w.x = cvt_pk_bf16(b0[0], b0[1]); w.y = cvt_pk_bf16(b0[2], b0[3]); w.z = cvt_pk_bf16(b1[0], b1[1]); w.w = cvt_pk_bf16(b1[2], b1[3]);
                    *(u32x4*)(rowp + 64) = w;
                }
        } else {
            const float sc = (u.pn == 8) ? 0.125f : 1.0f;
            const int col0 = u.pn * BM + wc * 32 + 8 * fq;
#pragma unroll
            for (int ai = 0; ai < 2; ++ai)
#pragma unroll
                for (int m = 0; m < 4; ++m) { bf16_t* rowp = O + (size_t)(row0 + ai * HALF + m * 16) * NPROJ + col0;
#pragma unroll
                    for (int bj = 0; bj < 2; ++bj) { const f32x4 v0 = acc[ai][bj][m][0] * sc, v1 = acc[ai][bj][m][1] * sc;
                        u32x4 w; w.x = cvt_pk_bf16(v0[0], v0[1]); w.y = cvt_pk_bf16(v0[2], v0[3]); w.z = cvt_pk_bf16(v1[0], v1[1]); w.w = cvt_pk_bf16(v1[2], v1[3]);
                        *(u32x4*)(rowp + bj * HALF) = w; } }
        }
    }
};
struct TailSplitOrder {
    StaticOrder full; int G, c, KS, ntp;
    __host__ __device__ void init(int G_, int c_, int K_, int KS_) { full.init(16384, 1024, G_, c_, K_); G = G_; c = c_; KS = KS_; ntp = K_ / BK / KS_; }
    __host__ __device__ bool next(int i, Unit& u) const {
        const long L = (long)i * G + c;
        if (L < 256) { StaticOrder f = full; f.G = 1; f.c = (int)L; return f.next(0, u); }
        const int s = (int)(L - 256); if (s >= 16 * KS) return false;
        const int tu = s / KS, part = s % KS; u.pm = 64 + (tu >> 2); u.pn = tu & 3; u.k0 = part * ntp * BK; u.nt = ntp; return true;
    }
    __device__ __forceinline__ void a_ready(const Unit&) const {}
    __device__ __forceinline__ void done(const Unit&) const {}
};
struct EpiRes {
    static constexpr bool PERM = false, AFTER_DRAIN = false;
    const float* base_p; const float* base_s; float* out; const float* gate; float* parts;
    __device__ __forceinline__ void operator()(const f32x4 (&acc)[2][2][4][2], const Unit& u, int wr, int wc, int fr, int fq) const {
        const int row0 = u.pm * BM + wr * 64 + fr, col0 = u.pn * BM + wc * 32 + 4 * fq;
#pragma unroll
        for (int ai = 0; ai < 2; ++ai)
#pragma unroll
            for (int m = 0; m < 4; ++m) {
                const int row = row0 + ai * HALF + m * 16;
                const float* brow = row < NTOKP ? base_p + (size_t)row * DM : base_s + (size_t)(row - NTOKP) * DM;
                const float* g = gate + (size_t)row_seq(row) * MODW;
                float* orow = out + (size_t)row * DM;
#pragma unroll
                for (int bj = 0; bj < 2; ++bj)
#pragma unroll
                    for (int n = 0; n < 2; ++n) { const int c = col0 + bj * HALF + n * 16;
                        if (u.pm >= 64) *(f32x4*)(parts + (size_t)(u.k0 / (u.nt * BK)) * 1048576 + (size_t)(row - NTOKP) * DM + c) = acc[ai][bj][m][n];
                        else { const f32x4 bv = *(const f32x4*)(brow + c), gv = *(const f32x4*)(g + c); *(f32x4*)(orow + c) = bv + gv * acc[ai][bj][m][n]; } }
            }
    }
};
struct EpiSwiGLU {
    static constexpr bool PERM = true, AFTER_DRAIN = false;
    bf16_t* O;
    __device__ __forceinline__ void operator()(const f32x4 (&acc)[2][2][4][2], const Unit& u, int wr, int wc, int fr, int fq) const {
        const int row0 = u.pm * BM + wr * 64 + fr, col0 = u.pn * HALF + wc * 32 + 8 * fq;
#pragma unroll
        for (int ai = 0; ai < 2; ++ai)
#pragma unroll
            for (int m = 0; m < 4; ++m) {
                float v[8];
#pragma unroll
                for (int n = 0; n < 2; ++n)
#pragma unroll
                    for (int e = 0; e < 4; ++e) { const float a = acc[ai][0][m][n][e], b = acc[ai][1][m][n][e];
                        v[n * 4 + e] = a * __builtin_amdgcn_rcpf(1.0f + __expf(-a)) * b; }
                u32x4 w; w.x = cvt_pk_bf16(v[0], v[1]); w.y = cvt_pk_bf16(v[2], v[3]); w.z = cvt_pk_bf16(v[4], v[5]); w.w = cvt_pk_bf16(v[6], v[7]);
                *(u32x4*)(O + (size_t)(row0 + ai * HALF + m * 16) * DFF + col0) = w;
            }
    }
};

template <class Epi, class Sched, bool ALIGN_EPI = false, bool SP2 = false>
__device__ __forceinline__ void gemm_phase(PG8_LAS unsigned char* lds, const Gemm g, const Sched& S, const Epi& E) {
    const int tid = threadIdx.x, wid = __builtin_amdgcn_readfirstlane(tid >> 6), lane = tid & 63, wr = wid >> 2, wc = wid & 3, fr = lane & 15, fq = lane >> 4;
    const int K = g.K;
    unsigned voffA[2], voffB[2];
#pragma unroll
    for (int i = 0; i < 2; ++i) { int R, C; stage_rc(tid * 16 + i * 8192, R, C); const int Rb = Epi::PERM ? ((R & ~31) + perm32(R & 31)) : R;
        voffA[i] = (unsigned)(R * K + C) * 2u; voffB[i] = (unsigned)(Rb * K + C) * 2u; }
    const size_t kstep = (size_t)(BK * 2);
    const size_t hstep = (size_t)HALF * K * 2;
    const size_t tstep = 2 * hstep;
    const unsigned ldsw = (unsigned)wid * 1024u;
    const int aoff = lds_byte(wr * 64 + fr, fq * 8), boff = lds_byte(wc * 32 + fr, fq * 8);
#define PG8_SA(b, h) (((b) * 2 + (h)) * HTB)
#define PG8_SB(b, h) ((4 + (b) * 2 + (h)) * HTB)
#define PG8_STAGE(bufoff, gbase, voff) do { _Pragma("unroll") for (int _i = 0; _i < 2; ++_i) \
        __builtin_amdgcn_global_load_lds((const unsigned*)((const char*)(gbase) + (voff)[_i]), (PG8_LAS unsigned*)(lds + (bufoff) + ldsw + _i * 8192), 16, 0, 0); } while (0)
#define PG8_LDA(dst, b, h) do { _Pragma("unroll") for (int m = 0; m < 4; ++m) _Pragma("unroll") for (int k = 0; k < 2; ++k) dst[m][k] = *(const PG8_LAS bf16x8*)(lds + PG8_SA(b, h) + aoff + m * 2048 + k * 1024); } while (0)
#define PG8_LDB(dst, b, h) do { _Pragma("unroll") for (int n = 0; n < 2; ++n) _Pragma("unroll") for (int k = 0; k < 2; ++k) dst[n][k] = *(const PG8_LAS bf16x8*)(lds + PG8_SB(b, h) + boff + n * 2048 + k * 1024); } while (0)
#define PG8_MMA(ai, bj, At, Bt) do { __builtin_amdgcn_s_setprio(1); _Pragma("unroll") for (int m = 0; m < 4; ++m) _Pragma("unroll") for (int n = 0; n < 2; ++n) _Pragma("unroll") for (int k = 0; k < 2; ++k) \
        acc[ai][bj][m][n] = __builtin_amdgcn_mfma_f32_16x16x32_bf16(Bt[n][k], At[m][k], acc[ai][bj][m][n], 0, 0, 0); __builtin_amdgcn_s_setprio(0); } while (0)
#define PG8_WAIT_V(n) asm volatile("s_waitcnt vmcnt(" #n ")" ::: "memory")
#define PG8_WAIT_L(n) asm volatile("s_waitcnt lgkmcnt(" #n ")" ::: "memory")
#define PG8_BAR __builtin_amdgcn_s_barrier()
#define PG8_SCHED __builtin_amdgcn_sched_barrier(0)
    Unit cur, nxt; int ui = 0;
    if (!S.next(0, cur)) return;
    f32x4 acc[2][2][4][2];
#pragma unroll
    for (int a = 0; a < 2; ++a)
#pragma unroll
        for (int b = 0; b < 2; ++b)
#pragma unroll
            for (int m = 0; m < 4; ++m)
#pragma unroll
                for (int n = 0; n < 2; ++n) acc[a][b][m][n] = (f32x4){0.f, 0.f, 0.f, 0.f};
    bf16x8 At[4][2], B0[2][2], B1[2][2];
    const char* cA = (const char*)g.A + (size_t)cur.pm * tstep + (size_t)cur.k0 * 2; const char* cB = (const char*)g.Bt + (size_t)cur.pn * tstep + (size_t)cur.k0 * 2; int nt = cur.nt;
    S.a_ready(cur);
    if constexpr (SP2) {
        PG8_STAGE(PG8_SB(0, 0), cB, voffB); PG8_STAGE(PG8_SB(0, 1), cB + hstep, voffB); PG8_STAGE(PG8_SA(0, 0), cA, voffA); PG8_STAGE(PG8_SA(0, 1), cA + hstep, voffA);
        if (wr == 1) PG8_BAR;
        PG8_WAIT_V(2); PG8_BAR;
        PG8_STAGE(PG8_SB(1, 0), cB + kstep, voffB); PG8_STAGE(PG8_SA(1, 0), cA + kstep, voffA); PG8_STAGE(PG8_SB(1, 1), cB + hstep + kstep, voffB);
        PG8_WAIT_V(6); PG8_BAR;
    } else {
        PG8_STAGE(PG8_SB(0, 0), cB, voffB); PG8_STAGE(PG8_SA(0, 0), cA, voffA); PG8_STAGE(PG8_SB(0, 1), cB + hstep, voffB); PG8_STAGE(PG8_SA(0, 1), cA + hstep, voffA);
        if (wr == 1) PG8_BAR;
        PG8_WAIT_V(4); PG8_BAR;
        PG8_STAGE(PG8_SB(1, 0), cB + kstep, voffB); PG8_STAGE(PG8_SA(1, 0), cA + kstep, voffA); PG8_STAGE(PG8_SB(1, 1), cB + hstep + kstep, voffB);
        PG8_WAIT_V(6); PG8_BAR;
    }
    for (;;) {
        const bool has_next = S.next(ui + 1, nxt);
        const char* nA = has_next ? (const char*)g.A + (size_t)nxt.pm * tstep + (size_t)nxt.k0 * 2 : cA; const char* nB = has_next ? (const char*)g.Bt + (size_t)nxt.pn * tstep + (size_t)nxt.k0 * 2 : cB;
        for (int t = 0; t < nt; t += 2) {
            const bool last = (t == nt - 2);
            const char* a1 = cA + (size_t)(t + 1) * kstep;
            const char* a2 = last ? nA : cA + (size_t)(t + 2) * kstep; const char* b2 = last ? nB : cB + (size_t)(t + 2) * kstep;
            const char* a3 = a2 + kstep; const char* b3 = b2 + kstep;
            if (last && has_next) S.a_ready(nxt);
            if constexpr (SP2) {
            PG8_LDB(B0, 0, 0); PG8_LDB(B1, 0, 1); PG8_SCHED; PG8_LDA(At, 0, 0); PG8_STAGE(PG8_SA(1, 1), a1 + hstep, voffA);
            PG8_WAIT_V(8); PG8_WAIT_L(0); PG8_BAR; PG8_MMA(0, 0, At, B0); PG8_MMA(0, 1, At, B1); PG8_BAR; PG8_SCHED;
            PG8_LDA(At, 0, 1); PG8_STAGE(PG8_SB(0, 0), b2, voffB); PG8_STAGE(PG8_SB(0, 1), b2 + hstep, voffB); PG8_STAGE(PG8_SA(0, 0), a2, voffA);
            PG8_WAIT_V(8); PG8_WAIT_L(0); PG8_BAR; PG8_MMA(1, 0, At, B0); PG8_MMA(1, 1, At, B1); PG8_BAR; PG8_SCHED;
            PG8_LDB(B0, 1, 0); PG8_LDB(B1, 1, 1); PG8_SCHED; PG8_LDA(At, 1, 0); PG8_STAGE(PG8_SA(0, 1), a2 + hstep, voffA);
            PG8_WAIT_V(8); PG8_WAIT_L(0); PG8_BAR; PG8_MMA(0, 0, At, B0); PG8_MMA(0, 1, At, B1); PG8_BAR; PG8_SCHED;
            PG8_LDA(At, 1, 1); PG8_STAGE(PG8_SB(1, 0), b3, voffB); PG8_STAGE(PG8_SB(1, 1), b3 + hstep, voffB); PG8_STAGE(PG8_SA(1, 0), a3, voffA);
            PG8_WAIT_V(8); PG8_WAIT_L(0); PG8_BAR; PG8_MMA(1, 0, At, B0); PG8_MMA(1, 1, At, B1); PG8_BAR; PG8_SCHED;
            } else {
            PG8_LDB(B0, 0, 0); PG8_SCHED; PG8_LDA(At, 0, 0); PG8_STAGE(PG8_SA(1, 1), a1 + hstep, voffA);
            PG8_WAIT_L(8); PG8_BAR; PG8_WAIT_L(0); PG8_MMA(0, 0, At, B0); PG8_BAR; PG8_SCHED;
            PG8_LDB(B1, 0, 1); PG8_STAGE(PG8_SB(0, 0), b2, voffB);
            PG8_BAR; PG8_WAIT_L(0); PG8_MMA(0, 1, At, B1); PG8_BAR;
            PG8_LDA(At, 0, 1); PG8_STAGE(PG8_SA(0, 0), a2, voffA);
            PG8_BAR; PG8_WAIT_L(0); PG8_MMA(1, 0, At, B0); PG8_BAR; PG8_SCHED;
            PG8_STAGE(PG8_SB(0, 1), b2 + hstep, voffB);
            PG8_WAIT_V(6); PG8_BAR; PG8_MMA(1, 1, At, B1); PG8_BAR;
            PG8_LDB(B0, 1, 0); PG8_SCHED; PG8_LDA(At, 1, 0); PG8_STAGE(PG8_SA(0, 1), a2 + hstep, voffA);
            PG8_WAIT_L(8); PG8_BAR; PG8_WAIT_L(0); PG8_MMA(0, 0, At, B0); PG8_BAR; PG8_SCHED;
            PG8_LDB(B1, 1, 1); PG8_STAGE(PG8_SB(1, 0), b3, voffB);
            PG8_BAR; PG8_WAIT_L(0); PG8_MMA(0, 1, At, B1); PG8_BAR;
            PG8_LDA(At, 1, 1); PG8_STAGE(PG8_SA(1, 0), a3, voffA);
            PG8_BAR; PG8_WAIT_L(0); PG8_MMA(1, 0, At, B0); PG8_BAR; PG8_SCHED;
            PG8_STAGE(PG8_SB(1, 1), b3 + hstep, voffB);
            PG8_WAIT_V(6); PG8_BAR; PG8_MMA(1, 1, At, B1); PG8_BAR;
            }
        }
        if constexpr (ALIGN_EPI) { if (wr == 0) PG8_BAR; }
        if constexpr (!Epi::AFTER_DRAIN) { E(acc, cur, wr, wc, fr, fq); S.done(cur); }
        if (!has_next) break;
#pragma unroll
        for (int a = 0; a < 2; ++a)
#pragma unroll
            for (int b = 0; b < 2; ++b)
#pragma unroll
                for (int m = 0; m < 4; ++m)
#pragma unroll
                    for (int n = 0; n < 2; ++n) acc[a][b][m][n] = (f32x4){0.f, 0.f, 0.f, 0.f};
        cur = nxt; cA = nA; cB = nB; nt = cur.nt; ++ui;
        if constexpr (ALIGN_EPI) { if (wr == 1) PG8_BAR; }
    }
    PG8_WAIT_V(0);
    if constexpr (!ALIGN_EPI) { if (wr == 0) PG8_BAR; }
    PG8_BAR;
    if constexpr (Epi::AFTER_DRAIN) { E.fused(acc, cur, wr, wc, fr, fq, lds, wid, lane); S.done(cur); }
#undef PG8_SA
#undef PG8_SB
#undef PG8_STAGE
#undef PG8_LDA
#undef PG8_LDB
#undef PG8_MMA
#undef PG8_WAIT_V
#undef PG8_WAIT_L
#undef PG8_BAR
#undef PG8_SCHED
}
}
#define LAS __attribute__((address_space(3)))
typedef unsigned short bf16;
typedef unsigned v4u __attribute__((ext_vector_type(4)));
typedef unsigned v2u __attribute__((ext_vector_type(2)));
typedef float f32x4 __attribute__((ext_vector_type(4)));
typedef short bf16x8 __attribute__((ext_vector_type(8)));
constexpr int NTHR = 512;
constexpr int LDS_BYTES = 147456;
constexpr size_t MiB = 1u << 20;
constexpr size_t WS_WIN = 1 * MiB, WS_WOUT = 9 * MiB, WS_WGU = 11 * MiB, WS_WDN = 22 * MiB, WS_MOD = 28 * MiB, WS_ROPE = 32 * MiB;
constexpr size_t WS_H = 34 * MiB, WS_MIX = 68 * MiB, WS_PROJ = 102 * MiB, WS_END = 230 * MiB;
constexpr size_t WS_SRET = WS_H, WS_SGLA = WS_H + 16 * MiB, WS_HID = WS_PROJ;
constexpr int ROPE_ROWS = 2056;
constexpr size_t WS_PART1 = WS_PROJ + 94 * MiB;
constexpr size_t WS_PART2 = WS_H;
constexpr size_t WS_BL = 31 * MiB + 256 * 1024;
constexpr int C_QR = 0, C_KR = 512, C_VR = 1024, C_GR = 1536, C_QG = 2048, C_KG = 2304, C_VG = 2560, C_GG = 3072, C_LR = 3584;
constexpr size_t O_Y = 0, O_SRP = (size_t)NTOK * DM, O_SGP = O_SRP + 8 * 4 * 128 * 128, O_SRS = O_SGP + 8 * 4 * 64 * 128, O_SGS = O_SRS + (size_t)128 * 4 * 128 * 128;

__device__ __forceinline__ float bf2f(unsigned h) { return __uint_as_float(h << 16); }
__device__ __forceinline__ unsigned pk2(float lo, float hi) { return pg8::cvt_pk_bf16(lo, hi); }
__device__ __forceinline__ bf16 f2bf(float f) { unsigned u = __float_as_uint(f); return (bf16)((u + 0x7fffu + ((u >> 16) & 1u)) >> 16); }
__device__ __forceinline__ float wave_sum(float v) {
#pragma unroll
    for (int o = 32; o >= 1; o >>= 1) v += __shfl_xor(v, o);
    return v;
}
__device__ __forceinline__ float silu_f(float a) { return a * __builtin_amdgcn_rcpf(1.0f + __expf(-a)); }
__device__ __forceinline__ float logsig16(float z) { return (fminf(z, 0.f) - __logf(1.0f + __expf(-fabsf(z)))) * 0.0625f; }
__device__ __forceinline__ bf16x8 frag(const LAS bf16* base, int row, int kofs, int ls) { return *(const LAS bf16x8*)(base + row * ls + kofs); }
#define MFMA16(a, b, c) __builtin_amdgcn_mfma_f32_16x16x32_bf16((a), (b), (c), 0, 0, 0)

template <int R, int C8> __device__ __forceinline__ void tile_g2l(const bf16* g, size_t gp, LAS bf16* l, int ls) {
    for (int idx = threadIdx.x; idx < R * C8; idx += NTHR) { const int r = idx / C8, c = idx % C8;
        const v4u v = *(const v4u*)(g + (size_t)r * gp + c * 8); *(LAS v4u*)(l + r * ls + c * 8) = v; }
}
template <int J, int V8> __device__ __forceinline__ void tile_g2l_T(const bf16* g, size_t gp, LAS bf16* l, int ls) {
    for (int idx = threadIdx.x; idx < V8 * (J / 2); idx += NTHR) { const int v8 = idx / (J / 2), jp = idx % (J / 2);
        const v4u a = *(const v4u*)(g + (size_t)(2 * jp) * gp + v8 * 8), b = *(const v4u*)(g + (size_t)(2 * jp + 1) * gp + v8 * 8);
#pragma unroll
        for (int e = 0; e < 4; ++e) {
            *(LAS unsigned*)(l + (v8 * 8 + 2 * e) * ls + 2 * jp) = (a[e] & 0xffffu) | (b[e] << 16);
            *(LAS unsigned*)(l + (v8 * 8 + 2 * e + 1) * ls + 2 * jp) = (a[e] >> 16) | (b[e] & 0xffff0000u);
        }
    }
}

struct Frame {
    const float *x_p, *x_s, *st_ret, *st_gla, *c_p, *c_s, *w_ada, *b_ada, *mix_norm, *w_in, *w_gk, *b_gk, *ret_norm, *gla_norm, *w_out, *ffn_norm, *w_gu, *w_dn, *fin_norm;
    float* out; unsigned char* ws;
    bf16 *WIN, *WOUT, *WGU, *WDN, *H, *MIX, *PROJ, *HID, *SRET, *SGLA; float *MOD, *RC, *RS, *UR, *UG, *BL;
};

__device__ __forceinline__ void p0_transpose_item(const float* W, int ldw, bf16* WT, int K, int kind, int item, LAS float* scr) {
    const int t = threadIdx.x, nkt = K / 256, nt = item / nkt, kt = item % nkt, r0 = nt * 64;
    int src0 = r0, valid = 64;
    if (kind == 0) { if (r0 < 1024) { const int pn = r0 >> 8, within = r0 & 255, bj = within >> 7, hl = (within & 127) >> 6; src0 = pn * 256 + hl * 128 + bj * 64; }
                     else { valid = 3600 - r0; valid = valid < 0 ? 0 : (valid > 64 ? 64 : valid); } }
    else if (kind == 1) { const int pn = r0 >> 8, within = r0 & 255, bj = within >> 7, idx = within & 127; src0 = bj * DFF + pn * 128 + idx; }
    const int c4 = (t & 15) * 4;
    f32x4 v[8];
#pragma unroll
    for (int i = 0; i < 8; ++i) { const int kk = (t >> 4) + 32 * i; v[i] = (f32x4){0.f, 0.f, 0.f, 0.f};
        if (c4 < valid) v[i] = __builtin_nontemporal_load((const f32x4*)(W + (size_t)(kt * 256 + kk) * ldw + src0 + c4)); }
#pragma unroll
    for (int i = 0; i < 8; ++i) { const int kk = (t >> 4) + 32 * i;
        scr[(c4 + 0) * 264 + kk] = v[i][0]; scr[(c4 + 1) * 264 + kk] = v[i][1]; scr[(c4 + 2) * 264 + kk] = v[i][2]; scr[(c4 + 3) * 264 + kk] = v[i][3]; }
    __syncthreads();
#pragma unroll
    for (int i = 0; i < 4; ++i) { const int c = t + NTHR * i, n = c >> 5, k8 = (c & 31) * 8;
        const f32x4 a = *(const LAS f32x4*)(scr + n * 264 + k8), b = *(const LAS f32x4*)(scr + n * 264 + k8 + 4);
        v4u w; w.x = pk2(a[0], a[1]); w.y = pk2(a[2], a[3]); w.z = pk2(b[0], b[1]); w.w = pk2(b[2], b[3]);
        *(v4u*)(WT + (size_t)(r0 + n) * K + kt * 256 + k8) = w; }
    __syncthreads();
}
__device__ __forceinline__ void p0_mod_slab(const Frame& F, int slab, LAS float* red) {
    const int t = threadIdx.x, lane = t & 63, w = __builtin_amdgcn_readfirstlane(t >> 6), l15 = lane & 15, quad = lane >> 4;
    f32x4 acc[9][2];
#pragma unroll
    for (int rt = 0; rt < 9; ++rt) { acc[rt][0] = (f32x4){0.f, 0.f, 0.f, 0.f}; acc[rt][1] = acc[rt][0]; }
#pragma unroll 1
    for (int ks = 0; ks < 4; ++ks) {
        const int k0 = w * 128 + ks * 32 + quad * 8;
        bf16x8 bfr[2];
#pragma unroll
        for (int ct = 0; ct < 2; ++ct) { const float* wp = F.w_ada + (size_t)k0 * MODW + slab * 32 + ct * 16 + l15; v4u p;
            p.x = pk2(__builtin_nontemporal_load(wp), __builtin_nontemporal_load(wp + MODW)); p.y = pk2(__builtin_nontemporal_load(wp + 2 * MODW), __builtin_nontemporal_load(wp + 3 * MODW));
            p.z = pk2(__builtin_nontemporal_load(wp + 4 * MODW), __builtin_nontemporal_load(wp + 5 * MODW)); p.w = pk2(__builtin_nontemporal_load(wp + 6 * MODW), __builtin_nontemporal_load(wp + 7 * MODW));
            bfr[ct] = __builtin_bit_cast(bf16x8, p); }
#pragma unroll
        for (int rt = 0; rt < 9; ++rt) { const int row = rt * 16 + l15; v4u p = (v4u){0u, 0u, 0u, 0u};
            if (row < 136) { const float* cp = (row < 8 ? F.c_p + row * DM : F.c_s + (row - 8) * DM) + k0; const f32x4 x0 = *(const f32x4*)cp, x1 = *(const f32x4*)(cp + 4);
                p.x = pk2(silu_f(x0[0]), silu_f(x0[1])); p.y = pk2(silu_f(x0[2]), silu_f(x0[3])); p.z = pk2(silu_f(x1[0]), silu_f(x1[1])); p.w = pk2(silu_f(x1[2]), silu_f(x1[3])); }
            const bf16x8 afr = __builtin_bit_cast(bf16x8, p);
            acc[rt][0] = MFMA16(afr, bfr[0], acc[rt][0]); acc[rt][1] = MFMA16(afr, bfr[1], acc[rt][1]); }
    }
    for (int ww = 0; ww < 8; ++ww) {
        if (w == ww) {
#pragma unroll
            for (int rt = 0; rt < 9; ++rt)
#pragma unroll
                for (int ct = 0; ct < 2; ++ct) { LAS f32x4* p = (LAS f32x4*)(red + (rt * 2 + ct) * 256 + lane * 4); if (ww == 0) *p = acc[rt][ct]; else *p = *p + acc[rt][ct]; }
        }
        __syncthreads();
    }
    for (int i = t; i < 18 * 256; i += NTHR) { const int tile = i >> 8, ln = (i >> 2) & 63, r = i & 3, rt = tile >> 1, ct = tile & 1;
        const int row = rt * 16 + (ln >> 4) * 4 + r, col = slab * 32 + ct * 16 + (ln & 15);
        if (row < 136) F.MOD[(size_t)row * MODW + col] = red[i] + F.b_ada[col]; }
    __syncthreads();
}
__device__ __forceinline__ void p0_prologue(const Frame& F, LAS unsigned char* lds) {
    const int G = gridDim.x, bx = blockIdx.x;
    LAS float* scr = (LAS float*)lds;
    for (int idx = bx * NTHR + threadIdx.x; idx < ROPE_ROWS * 64; idx += G * NTHR) { const int p = idx >> 6, j = idx & 63; const int pos = p < 2048 ? p : 16384 + (p - 2048);
        const float inv = (float)exp2(-(double)j * (13.287712379549449 / 64.0)); const float ang = (float)pos * inv;
        double rev = (double)ang * 0.15915494309189535; rev -= __builtin_rint(rev); const float fr = (float)rev;
        F.RC[idx] = __builtin_amdgcn_cosf(fr); F.RS[idx] = __builtin_amdgcn_sinf(fr); }
    for (int s = bx; s < 192; s += G) p0_mod_slab(F, s, scr);
    constexpr int N_IN = 60 * 4, N_OUT = 16 * 4, N_GU = 88 * 4, N_DN = 16 * 11;
    for (int it = (bx + G - (192 % G)) % G; it < N_IN + N_OUT + N_GU + N_DN; it += G) {
        if (it < N_IN) p0_transpose_item(F.w_in, 3600, F.WIN, DM, 0, it, scr);
        else if (it < N_IN + N_OUT) p0_transpose_item(F.w_out, DM, F.WOUT, DM, 2, it - N_IN, scr);
        else if (it < N_IN + N_OUT + N_GU) p0_transpose_item(F.w_gu, 2 * DFF, F.WGU, DM, 1, it - N_IN - N_OUT, scr);
        else p0_transpose_item(F.w_dn, DM, F.WDN, DFF, 2, it - N_IN - N_OUT - N_GU, scr);
    }
}
template <bool MODULATE> __device__ __forceinline__ void norm_phase(const float* xp, const float* xs, const float* gain, const float* mod, int shi, int sci, bf16* H, float* Y,
                                                                    const float* parts, int nparts, const float* gate) {
    const int lane = threadIdx.x & 63, gw = blockIdx.x * 8 + (threadIdx.x >> 6), nw = gridDim.x * 8;
    f32x4 g[4];
#pragma unroll
    for (int i = 0; i < 4; ++i) g[i] = *(const f32x4*)(gain + 4 * lane + 256 * i);
    for (int row = gw; row < NTOK; row += nw) {
        const float* x = row < NTOKP ? xp + (size_t)row * DM : xs + (size_t)(row - NTOKP) * DM;
        f32x4 v[4];
#pragma unroll
        for (int i = 0; i < 4; ++i) v[i] = *(const f32x4*)(x + 4 * lane + 256 * i);
        if (nparts > 0 && row >= NTOKP) {
            const float* gp = gate + (size_t)row_seq(row) * MODW; const float* pp = parts + (size_t)(row - NTOKP) * DM;
#pragma unroll
            for (int i = 0; i < 4; ++i) { const int c = 4 * lane + 256 * i; f32x4 s = (f32x4){0.f, 0.f, 0.f, 0.f};
                for (int p = 0; p < nparts; ++p) s += *(const f32x4*)(pp + (size_t)p * 1048576 + c);
                v[i] += *(const f32x4*)(gp + c) * s;
                if (MODULATE) *(f32x4*)(Y + (size_t)row * DM + c) = v[i]; }
        }
        float ss = 0.f;
#pragma unroll
        for (int i = 0; i < 4; ++i) ss += v[i][0] * v[i][0] + v[i][1] * v[i][1] + v[i][2] * v[i][2] + v[i][3] * v[i][3];
        ss = wave_sum(ss);
        const float rstd = rsqrtf(ss * (1.0f / DM) + 1e-6f);
        if (MODULATE) {
            const float* m = mod + (size_t)row_seq(row) * MODW;
#pragma unroll
            for (int i = 0; i < 4; ++i) { const int c = 4 * lane + 256 * i;
                const f32x4 sc = *(const f32x4*)(m + sci * DM + c), sh = *(const f32x4*)(m + shi * DM + c);
                const f32x4 o = v[i] * rstd * g[i] * (sc + 1.0f) + sh;
                v2u w; w.x = pk2(o[0], o[1]); w.y = pk2(o[2], o[3]); *(v2u*)(H + (size_t)row * DM + c) = w; }
        } else {
#pragma unroll
            for (int i = 0; i < 4; ++i) { const int c = 4 * lane + 256 * i; *(f32x4*)(Y + (size_t)row * DM + c) = v[i] * rstd * g[i]; }
        }
    }
}
typedef short s16x4 __attribute__((ext_vector_type(4)));
__device__ __forceinline__ bf16x8 frag_tr(const LAS bf16* base, int krow0, int col0, int ls, int lane) {
    const int l15 = lane & 15, quad = lane >> 4;
    const LAS bf16* a = base + (krow0 + quad * 8 + (l15 >> 2)) * ls + col0 + 4 * (l15 & 3);
    const s16x4 lo = __builtin_bit_cast(s16x4, __builtin_amdgcn_ds_read_tr16_b64_v4i16((LAS s16x4*)a));
    const s16x4 hi = __builtin_bit_cast(s16x4, __builtin_amdgcn_ds_read_tr16_b64_v4i16((LAS s16x4*)(a + 4 * ls)));
    return (bf16x8){lo[0], lo[1], lo[2], lo[3], hi[0], hi[1], hi[2], hi[3]};
}
__device__ __forceinline__ void ret_u_item(const Frame& F, int item, LAS unsigned char* lds) {
    const int b = item >> 6, h = (item >> 4) & 3, n = item & 15;
    const int t = threadIdx.x, lane = t & 63, w = __builtin_amdgcn_readfirstlane(t >> 6), l15 = lane & 15, quad = lane >> 4;
    LAS bf16* Ks = (LAS bf16*)lds; LAS bf16* Vs = Ks + 128 * 136;
    const size_t row0 = (size_t)b * 2048 + n * 128;
    const float lg2 = log1pf(-exp2f(-5.0f - (float)h)) * 1.4426950408889634f;
    tile_g2l<128, 16>(F.PROJ + row0 * NPROJ + C_KR + h * 128, NPROJ, Ks, 136);
    for (int idx = t; idx < 128 * 16; idx += NTHR) { const int j = idx >> 4, c = idx & 15;
        const v4u v = *(const v4u*)(F.PROJ + (row0 + j) * NPROJ + C_VR + h * 128 + c * 8); const float dec = __builtin_amdgcn_exp2f(lg2 * (float)(127 - j));
        v4u o;
#pragma unroll
        for (int e = 0; e < 4; ++e) o[e] = pk2(bf2f(v[e] & 0xffffu) * dec, bf2f(v[e] >> 16) * dec);
        *(LAS v4u*)(Vs + j * 136 + c * 8) = o; }
    __syncthreads();
    bf16x8 av[4];
#pragma unroll
    for (int ks = 0; ks < 4; ++ks) av[ks] = frag_tr(Vs, ks * 32, 16 * w, 136, lane);
    float* U = F.UR + (size_t)item * 16384;
#pragma unroll
    for (int dt = 0; dt < 8; ++dt) { f32x4 acc = (f32x4){0.f, 0.f, 0.f, 0.f};
#pragma unroll
        for (int ks = 0; ks < 4; ++ks) acc = MFMA16(av[ks], frag_tr(Ks, ks * 32, 16 * dt, 136, lane), acc);
#pragma unroll
        for (int r = 0; r < 4; ++r) U[(16 * w + quad * 4 + r) * 128 + 16 * dt + l15] = acc[r]; }
    __syncthreads();
}
__device__ __forceinline__ void gla_gk_cumsum(const Frame& F, int h, size_t row0, LAS float* bcum, LAS float* lrs, LAS float* tot) {
    const int t = threadIdx.x, dcol = t & 63, jg = t >> 6;
    if (t < 128) { const int j = t >> 1, hf = t & 1; const v4u v = *(const v4u*)(F.PROJ + (row0 + j) * NPROJ + C_LR + hf * 8);
#pragma unroll
        for (int e = 0; e < 4; ++e) { lrs[j * 16 + hf * 8 + 2 * e] = bf2f(v[e] & 0xffffu); lrs[j * 16 + hf * 8 + 2 * e + 1] = bf2f(v[e] >> 16); } }
    float w2[16];
#pragma unroll
    for (int r = 0; r < 16; ++r) w2[r] = F.w_gk[r * 256 + h * 64 + dcol];
    const float bias = F.b_gk[h * 64 + dcol];
    __syncthreads();
    float gl[8]; float run = 0.f;
#pragma unroll
    for (int i = 0; i < 8; ++i) { float z = bias;
#pragma unroll
        for (int r4 = 0; r4 < 4; ++r4) { const f32x4 l = *(const LAS f32x4*)(lrs + (jg * 8 + i) * 16 + r4 * 4); z += l[0] * w2[r4 * 4] + l[1] * w2[r4 * 4 + 1] + l[2] * w2[r4 * 4 + 2] + l[3] * w2[r4 * 4 + 3]; }
        run += logsig16(z); gl[i] = run; }
    tot[jg * 64 + dcol] = run;
    __syncthreads();
    float pre = 0.f;
#pragma unroll
    for (int q = 0; q < 8; ++q) { const float v = tot[q * 64 + dcol]; pre += (q < jg) ? v : 0.f; }
#pragma unroll
    for (int i = 0; i < 8; ++i) bcum[(jg * 8 + i) * 64 + dcol] = pre + gl[i];
    __syncthreads();
}
__device__ __forceinline__ void gla_u_item(const Frame& F, int item, LAS unsigned char* lds) {
    const int b = item >> 7, h = (item >> 5) & 3, n = item & 31;
    const int t = threadIdx.x, lane = t & 63, w = __builtin_amdgcn_readfirstlane(t >> 6), l15 = lane & 15, quad = lane >> 4;
    LAS bf16* Ks = (LAS bf16*)lds;
    LAS bf16* Vs = Ks + 64 * 72;
    LAS float* bcum = (LAS float*)(lds + 32768);
    LAS float* lrs = bcum + 4096;
    LAS float* tot = lrs + 1024;
    const size_t row0 = (size_t)b * 2048 + n * 64;
    tile_g2l<64, 16>(F.PROJ + row0 * NPROJ + C_VG + h * 128, NPROJ, Vs, 136);
    const int i = t >> 3, d8 = (t & 7) * 8;
    const v4u k = *(const v4u*)(F.PROJ + (row0 + i) * NPROJ + C_KG + h * 64 + d8);
    gla_gk_cumsum(F, h, row0, bcum, lrs, tot);
    { const f32x4 b0 = *(const LAS f32x4*)(bcum + i * 64 + d8), b1 = *(const LAS f32x4*)(bcum + i * 64 + d8 + 4);
      const f32x4 l0 = *(const LAS f32x4*)(bcum + 63 * 64 + d8), l1 = *(const LAS f32x4*)(bcum + 63 * 64 + d8 + 4);
      const f32x4 e0 = l0 - b0, e1 = l1 - b1; v4u ko;
      ko.x = pk2(bf2f(k.x & 0xffffu) * __expf(e0[0]), bf2f(k.x >> 16) * __expf(e0[1])); ko.y = pk2(bf2f(k.y & 0xffffu) * __expf(e0[2]), bf2f(k.y >> 16) * __expf(e0[3]));
      ko.z = pk2(bf2f(k.z & 0xffffu) * __expf(e1[0]), bf2f(k.z >> 16) * __expf(e1[1])); ko.w = pk2(bf2f(k.w & 0xffffu) * __expf(e1[2]), bf2f(k.w >> 16) * __expf(e1[3]));
      *(LAS v4u*)(Ks + i * 72 + d8) = ko; }
    if (t < 64) F.BL[(size_t)item * 64 + t] = bcum[63 * 64 + t];
    __syncthreads();
    bf16x8 av[2];
#pragma unroll
    for (int ks = 0; ks < 2; ++ks) av[ks] = frag_tr(Vs, ks * 32, 16 * w, 136, lane);
    float* U = F.UG + (size_t)item * 8192;
#pragma unroll
    for (int dt = 0; dt < 4; ++dt) { f32x4 acc = (f32x4){0.f, 0.f, 0.f, 0.f};
#pragma unroll
        for (int ks = 0; ks < 2; ++ks) acc = MFMA16(av[ks], frag_tr(Ks, ks * 32, 16 * dt, 72, lane), acc);
#pragma unroll
        for (int r = 0; r < 4; ++r) U[(16 * w + quad * 4 + r) * 64 + 16 * dt + l15] = acc[r]; }
    __syncthreads();
}
__device__ __forceinline__ void scan_phase(const Frame& F) {
    for (int gt = blockIdx.x * NTHR + threadIdx.x; gt < 98304; gt += gridDim.x * NTHR) {
        float S[8];
#pragma unroll
        for (int e = 0; e < 8; ++e) S[e] = 0.f;
        if (gt < 65536) {
            const int bh = gt >> 11, e2 = gt & 2047, v = e2 >> 4, d8 = (e2 & 15) * 8;
            const float gC = exp2f(log1pf(-exp2f(-5.0f - (float)(bh & 3))) * 1.4426950408889634f * 128.0f);
            const float* U = F.UR + (size_t)bh * 16 * 16384 + v * 128 + d8; bf16* Sp = F.SRET + (size_t)bh * 16 * 16384 + v * 128 + d8;
            for (int n0 = 0; n0 < 16; n0 += 4) { f32x4 u[4][2];
#pragma unroll
                for (int k = 0; k < 4; ++k) { u[k][0] = *(const f32x4*)(U + (size_t)(n0 + k) * 16384); u[k][1] = *(const f32x4*)(U + (size_t)(n0 + k) * 16384 + 4); }
#pragma unroll
                for (int k = 0; k < 4; ++k) { v4u o; o.x = pk2(S[0], S[1]); o.y = pk2(S[2], S[3]); o.z = pk2(S[4], S[5]); o.w = pk2(S[6], S[7]);
                    *(v4u*)(Sp + (size_t)(n0 + k) * 16384) = o;
#pragma unroll
                    for (int e = 0; e < 8; ++e) S[e] = gC * S[e] + u[k][e >> 2][e & 3]; } }
            float* so = F.out + O_SRP + (size_t)bh * 16384;
#pragma unroll
            for (int e = 0; e < 8; ++e) so[(d8 + e) * 128 + v] = S[e];
        } else {
            const int g2 = gt - 65536, bh = g2 >> 10, e2 = g2 & 1023, v = e2 >> 3, d8 = (e2 & 7) * 8;
            const float* U = F.UG + (size_t)bh * 32 * 8192 + v * 64 + d8; bf16* Sp = F.SGLA + (size_t)bh * 32 * 8192 + v * 64 + d8; const float* BLp = F.BL + (size_t)bh * 32 * 64 + d8;
            for (int n0 = 0; n0 < 32; n0 += 4) { f32x4 u[4][2], bl[4][2];
#pragma unroll
                for (int k = 0; k < 4; ++k) { u[k][0] = *(const f32x4*)(U + (size_t)(n0 + k) * 8192); u[k][1] = *(const f32x4*)(U + (size_t)(n0 + k) * 8192 + 4);
                    bl[k][0] = *(const f32x4*)(BLp + (n0 + k) * 64); bl[k][1] = *(const f32x4*)(BLp + (n0 + k) * 64 + 4); }
#pragma unroll
                for (int k = 0; k < 4; ++k) { v4u o; o.x = pk2(S[0], S[1]); o.y = pk2(S[2], S[3]); o.z = pk2(S[4], S[5]); o.w = pk2(S[6], S[7]);
                    *(v4u*)(Sp + (size_t)(n0 + k) * 8192) = o;
#pragma unroll
                    for (int e = 0; e < 8; ++e) S[e] = __expf(bl[k][e >> 2][e & 3]) * S[e] + u[k][e >> 2][e & 3]; } }
            float* so = F.out + O_SGP + (size_t)bh * 8192;
#pragma unroll
            for (int e = 0; e < 8; ++e) so[(d8 + e) * 128 + v] = S[e];
        }
    }
}
template <int DK, bool GLA> __device__ __forceinline__ void sample_item(const Frame& F, int bs, int h, LAS unsigned char* lds) {
    const int t = threadIdx.x, lane = t & 63, w = t >> 6;
    LAS float* qs = (LAS float*)lds;
    LAS float* ks = qs + 8 * DK;
    LAS float* dc = ks + 8 * DK;
    LAS float* vs = dc + 8 * DK;
    LAS float* part = vs + 8 * 128;
    LAS float* lrs = part + 4 * 8 * 128;
    constexpr int DPT = DK / 4;
    const int v = t & 127, dq = t >> 7, d0 = dq * DPT;
    const float* S0 = (GLA ? F.st_gla : F.st_ret) + (size_t)(bs * 4 + h) * DK * 128;
    float* So = F.out + (GLA ? O_SGS : O_SRS) + (size_t)(bs * 4 + h) * DK * 128;
    float S[DPT];
#pragma unroll
    for (int i = 0; i < DPT; ++i) S[i] = __builtin_nontemporal_load(S0 + (d0 + i) * 128 + v);
    const size_t row0 = (size_t)NTOKP + bs * 8;
    const int qcol = GLA ? C_QG + h * 64 : C_QR + h * 128, kcol = GLA ? C_KG + h * 64 : C_KR + h * 128;
    const int vcol = GLA ? C_VG + h * 128 : C_VR + h * 128, gcol = GLA ? C_GG + h * 128 : C_GR + h * 128;
    for (int idx = t; idx < 8 * DK; idx += NTHR) { const int tok = idx / DK, d = idx % DK;
        qs[idx] = bf2f(F.PROJ[(row0 + tok) * NPROJ + qcol + d]); ks[idx] = bf2f(F.PROJ[(row0 + tok) * NPROJ + kcol + d]); }
    for (int idx = t; idx < 8 * 128; idx += NTHR) { const int tok = idx >> 7, v = idx & 127; vs[idx] = bf2f(F.PROJ[(row0 + tok) * NPROJ + vcol + v]); }
    if (GLA) { if (t < 128) lrs[t] = bf2f(F.PROJ[(row0 + (t >> 4)) * NPROJ + C_LR + (t & 15)]); }
    __syncthreads();
    if (GLA) { const int tok = t >> 6, d = t & 63; float z = F.b_gk[h * 64 + d];
#pragma unroll
        for (int r = 0; r < 16; ++r) z += lrs[tok * 16 + r] * F.w_gk[r * 256 + h * 64 + d];
        dc[t] = __expf(logsig16(z));
        __syncthreads(); }
    const float gam = 1.0f - exp2f(-5.0f - (float)h);
#pragma unroll
    for (int tok = 0; tok < 8; ++tok) { const float vv = vs[tok * 128 + v]; float po = 0.f;
#pragma unroll
        for (int i4 = 0; i4 < DPT; i4 += 4) {
            const f32x4 kk = *(const LAS f32x4*)(ks + tok * DK + d0 + i4), qq = *(const LAS f32x4*)(qs + tok * DK + d0 + i4);
            f32x4 dd = (f32x4){gam, gam, gam, gam}; if (GLA) dd = *(const LAS f32x4*)(dc + tok * DK + d0 + i4);
#pragma unroll
            for (int e = 0; e < 4; ++e) { S[i4 + e] = dd[e] * S[i4 + e] + kk[e] * vv; po += qq[e] * S[i4 + e]; } }
        part[(dq * 8 + tok) * 128 + v] = po; }
#pragma unroll
    for (int i = 0; i < DPT; ++i) __builtin_nontemporal_store(S[i], So + (d0 + i) * 128 + v);
    __syncthreads();
    { const int tok = w; const size_t row = row0 + tok; const float* gain = (GLA ? F.gla_norm : F.ret_norm) + h * 128;
      float o[2];
#pragma unroll
      for (int q = 0; q < 2; ++q) { const int vv = lane + 64 * q; o[q] = part[(0 * 8 + tok) * 128 + vv] + part[(1 * 8 + tok) * 128 + vv] + part[(2 * 8 + tok) * 128 + vv] + part[(3 * 8 + tok) * 128 + vv]; }
      const float ss = wave_sum(o[0] * o[0] + o[1] * o[1]);
      const float rstd = rsqrtf(ss * (1.0f / 128.0f) + 1e-6f);
#pragma unroll
      for (int q = 0; q < 2; ++q) { const int vv = lane + 64 * q; const float g = bf2f(F.PROJ[row * NPROJ + gcol + vv]);
          F.MIX[row * DM + (GLA ? 512 : 0) + h * 128 + vv] = f2bf(o[q] * rstd * gain[vv] * silu_f(g)); } }
    __syncthreads();
}
__device__ __forceinline__ void ret_pass2(const Frame& F, int item, LAS unsigned char* lds) {
    const int b = item >> 6, h = (item >> 4) & 3, n = item & 15;
    const int t = threadIdx.x, lane = t & 63, w = __builtin_amdgcn_readfirstlane(t >> 6), l15 = lane & 15, quad = lane >> 4;
    LAS bf16* Qs = (LAS bf16*)lds; LAS bf16* Ks = Qs + 128 * 136; LAS bf16* Vt = Ks + 128 * 136; LAS bf16* St = Vt + 128 * 136;
    const size_t row0 = (size_t)b * 2048 + n * 128;
    tile_g2l<128, 16>(F.PROJ + row0 * NPROJ + C_QR + h * 128, NPROJ, Qs, 136);
    tile_g2l<128, 16>(F.PROJ + row0 * NPROJ + C_KR + h * 128, NPROJ, Ks, 136);
    tile_g2l<128, 16>(F.SRET + (size_t)((b * 4 + h) * 16 + n) * 16384, 128, St, 136);
    tile_g2l<128, 16>(F.PROJ + row0 * NPROJ + C_VR + h * 128, NPROJ, Vt, 136);
    __syncthreads();
    const float lg2 = log1pf(-exp2f(-5.0f - (float)h)) * 1.4426950408889634f;
    const int i0 = 16 * w;
    bf16x8 qa[4];
#pragma unroll
    for (int ks = 0; ks < 4; ++ks) qa[ks] = frag(Qs, i0 + l15, ks * 32 + quad * 8, 136);
    f32x4 acc[8];
#pragma unroll
    for (int vt = 0; vt < 8; ++vt) { acc[vt] = (f32x4){0.f, 0.f, 0.f, 0.f};
#pragma unroll
        for (int ks = 0; ks < 4; ++ks) acc[vt] = MFMA16(qa[ks], frag(St, 16 * vt + l15, ks * 32 + quad * 8, 136), acc[vt]); }
    { f32x4 sc;
#pragma unroll
      for (int r = 0; r < 4; ++r) sc[r] = __builtin_amdgcn_exp2f(lg2 * (float)(i0 + quad * 4 + r + 1));
#pragma unroll
      for (int vt = 0; vt < 8; ++vt) acc[vt] = acc[vt] * sc; }
    LAS bf16* At = Qs + i0 * 136;
    asm volatile("s_waitcnt lgkmcnt(0)" ::: "memory");
    const int njt = (w | 1) + 1;
    for (int jt = 0; jt < njt; ++jt) {
        f32x4 sv = (f32x4){0.f, 0.f, 0.f, 0.f};
        if (jt <= w) {
#pragma unroll
            for (int ks = 0; ks < 4; ++ks) sv = MFMA16(qa[ks], frag(Ks, 16 * jt + l15, ks * 32 + quad * 8, 136), sv); }
#pragma unroll
        for (int r = 0; r < 4; ++r) { const int diff = (i0 + quad * 4 + r) - (16 * jt + l15);
            const float val = diff >= 0 ? sv[r] * __builtin_amdgcn_exp2f(lg2 * (float)diff) : 0.f;
            At[(quad * 4 + r) * 136 + 16 * jt + l15] = f2bf(val); }
    }
    asm volatile("s_waitcnt lgkmcnt(0)" ::: "memory");
    const int nks = (w >> 1) + 1;
    for (int ks = 0; ks < nks; ++ks) { const bf16x8 aa = frag(At, l15, ks * 32 + quad * 8, 136);
#pragma unroll
        for (int vt = 0; vt < 8; ++vt) acc[vt] = MFMA16(aa, frag_tr(Vt, ks * 32, 16 * vt, 136, lane), acc[vt]); }
    f32x4 ss = (f32x4){0.f, 0.f, 0.f, 0.f};
#pragma unroll
    for (int vt = 0; vt < 8; ++vt) ss += acc[vt] * acc[vt];
#pragma unroll
    for (int r = 0; r < 4; ++r) { float v = ss[r]; v += __shfl_xor(v, 1); v += __shfl_xor(v, 2); v += __shfl_xor(v, 4); v += __shfl_xor(v, 8); ss[r] = rsqrtf(v * (1.0f / 128.0f) + 1e-6f); }
#pragma unroll
    for (int vt = 0; vt < 8; ++vt) { const int col = h * 128 + 16 * vt + l15; const float gn = F.ret_norm[col];
#pragma unroll
        for (int r = 0; r < 4; ++r) { const size_t row = row0 + i0 + quad * 4 + r; const float g = bf2f(F.PROJ[row * NPROJ + C_GR + col]);
            F.MIX[row * DM + col] = f2bf(acc[vt][r] * ss[r] * gn * silu_f(g)); } }
    __syncthreads();
}
__device__ __forceinline__ void gla_pass2(const Frame& F, int item, LAS unsigned char* lds) {
    const int b = item >> 7, h = (item >> 5) & 3, n = item & 31;
    const int t = threadIdx.x, lane = t & 63, w = __builtin_amdgcn_readfirstlane(t >> 6), l15 = lane & 15, quad = lane >> 4;
    LAS bf16* Qs = (LAS bf16*)lds;
    LAS bf16* Ks = Qs + 64 * 72;
    LAS bf16* Vt = Ks + 64 * 72;
    LAS bf16* St = Vt + 64 * 136;
    LAS bf16* Aw = St + 128 * 72;
    LAS float* bcum = (LAS float*)(lds + 73728);
    LAS float* lrs = bcum + 4096;
    LAS float* tot = lrs + 1024;
    LAS float* ssx = tot + 512;
    const size_t row0 = (size_t)b * 2048 + n * 64;
    tile_g2l<64, 16>(F.PROJ + row0 * NPROJ + C_VG + h * 128, NPROJ, Vt, 136);
    tile_g2l<128, 8>(F.SGLA + (size_t)((b * 4 + h) * 32 + n) * 8192, 64, St, 72);
    gla_gk_cumsum(F, h, row0, bcum, lrs, tot);
    { const int i = t >> 3, d8 = (t & 7) * 8;
      const v4u q = *(const v4u*)(F.PROJ + (row0 + i) * NPROJ + C_QG + h * 64 + d8), k = *(const v4u*)(F.PROJ + (row0 + i) * NPROJ + C_KG + h * 64 + d8);
      const f32x4 b0 = *(const LAS f32x4*)(bcum + i * 64 + d8), b1 = *(const LAS f32x4*)(bcum + i * 64 + d8 + 4);
      v4u qo, ko;
#pragma unroll
      for (int e = 0; e < 4; ++e) { const float ba = e < 2 ? b0[2 * e] : b1[2 * e - 4], bb = e < 2 ? b0[2 * e + 1] : b1[2 * e - 3];
          const float ea = __expf(ba), eb = __expf(bb);
          qo[e] = pk2(bf2f(q[e] & 0xffffu) * ea, bf2f(q[e] >> 16) * eb);
          ko[e] = pk2(bf2f(k[e] & 0xffffu) * __builtin_amdgcn_rcpf(ea), bf2f(k[e] >> 16) * __builtin_amdgcn_rcpf(eb)); }
      *(LAS v4u*)(Qs + i * 72 + d8) = qo; *(LAS v4u*)(Ks + i * 72 + d8) = ko; }
    __syncthreads();
    const int rt = w & 3, vh = w >> 2, i0 = 16 * rt;
    bf16x8 qa[2];
#pragma unroll
    for (int ks = 0; ks < 2; ++ks) qa[ks] = frag(Qs, i0 + l15, ks * 32 + quad * 8, 72);
    f32x4 acc[4];
#pragma unroll
    for (int v4 = 0; v4 < 4; ++v4) { acc[v4] = (f32x4){0.f, 0.f, 0.f, 0.f};
#pragma unroll
        for (int ks = 0; ks < 2; ++ks) acc[v4] = MFMA16(qa[ks], frag(St, 16 * (vh * 4 + v4) + l15, ks * 32 + quad * 8, 72), acc[v4]); }
    LAS bf16* At = Aw + w * 16 * 72;
    const int njt = (rt | 1) + 1;
    for (int jt = 0; jt < njt; ++jt) {
        f32x4 sv = (f32x4){0.f, 0.f, 0.f, 0.f};
        if (jt <= rt) {
#pragma unroll
            for (int ks = 0; ks < 2; ++ks) sv = MFMA16(qa[ks], frag(Ks, 16 * jt + l15, ks * 32 + quad * 8, 72), sv); }
#pragma unroll
        for (int r = 0; r < 4; ++r) { const int diff = (i0 + quad * 4 + r) - (16 * jt + l15);
            At[(quad * 4 + r) * 72 + 16 * jt + l15] = f2bf(diff >= 0 ? sv[r] : 0.f); }
    }
    asm volatile("s_waitcnt lgkmcnt(0)" ::: "memory");
    const int nks = (rt >> 1) + 1;
    for (int ks = 0; ks < nks; ++ks) { const bf16x8 aa = frag(At, l15, ks * 32 + quad * 8, 72);
#pragma unroll
        for (int v4 = 0; v4 < 4; ++v4) acc[v4] = MFMA16(aa, frag_tr(Vt, ks * 32, 16 * (vh * 4 + v4), 136, lane), acc[v4]); }
    f32x4 ss = (f32x4){0.f, 0.f, 0.f, 0.f};
#pragma unroll
    for (int v4 = 0; v4 < 4; ++v4) ss += acc[v4] * acc[v4];
#pragma unroll
    for (int r = 0; r < 4; ++r) { float v = ss[r]; v += __shfl_xor(v, 1); v += __shfl_xor(v, 2); v += __shfl_xor(v, 4); v += __shfl_xor(v, 8); ss[r] = v; }
    if (l15 == 0) { ssx[w * 16 + quad * 4 + 0] = ss[0]; ssx[w * 16 + quad * 4 + 1] = ss[1]; ssx[w * 16 + quad * 4 + 2] = ss[2]; ssx[w * 16 + quad * 4 + 3] = ss[3]; }
    __syncthreads();
#pragma unroll
    for (int r = 0; r < 4; ++r) ss[r] = rsqrtf((ssx[w * 16 + quad * 4 + r] + ssx[(w ^ 4) * 16 + quad * 4 + r]) * (1.0f / 128.0f) + 1e-6f);
#pragma unroll
    for (int v4 = 0; v4 < 4; ++v4) { const int hv = h * 128 + 16 * (vh * 4 + v4) + l15; const float gn = F.gla_norm[hv];
#pragma unroll
        for (int r = 0; r < 4; ++r) { const size_t row = row0 + i0 + quad * 4 + r; const float g = bf2f(F.PROJ[row * NPROJ + C_GG + hv]);
            F.MIX[row * DM + 512 + hv] = f2bf(acc[v4][r] * ss[r] * gn * silu_f(g)); } }
    __syncthreads();
}
#define XB_TMO      128
#define XB_XCNT(j)  (256  + 64 * (j))
#define XB_XSUB(j)  (1280 + 64 * (j))
#define XB_XGEN(j)  (2304 + 64 * (j))
#define XB_TOP      3328
#define XB_TOPGEN   3392
#define XCD_BAR_WORDS 3456
#define XB_SPIN_CAP (1u << 18)

__device__ __forceinline__ unsigned xb_ld(unsigned* p)              { return __hip_atomic_load(p, __ATOMIC_RELAXED, __HIP_MEMORY_SCOPE_AGENT); }
__device__ __forceinline__ unsigned xb_add(unsigned* p, unsigned v) { return __hip_atomic_fetch_add(p, v, __ATOMIC_RELAXED, __HIP_MEMORY_SCOPE_AGENT); }
__device__ __forceinline__ unsigned xb_xcc_id() { return (unsigned)__builtin_amdgcn_s_getreg((3 << 11) | 20) & 0xFu; }
#define XB_SPIN(cond, bar) do { unsigned _sp = 0; while (cond) { __builtin_amdgcn_s_sleep(1); \
    if ((++_sp & 255u) == 0u) { if (xb_ld(&(bar)[XB_TMO])) break; if (_sp > XB_SPIN_CAP) { atomicAdd(&(bar)[XB_TMO], 1u); break; } } } } while (0)

struct XcdBarrier {
    unsigned* bar; unsigned x;
    volatile LAS unsigned* st;
};

__device__ __forceinline__ XcdBarrier xcd_barrier_post(unsigned* bar, volatile LAS unsigned* st) {
    XcdBarrier b; b.bar = bar; b.x = xb_xcc_id(); b.st = st;
    if (threadIdx.x == 0) (void)xb_add(&bar[XB_XCNT(b.x)], 1u);
    return b;
}
__device__ __forceinline__ void xcd_barrier_complete(unsigned* bar, unsigned x, unsigned& nloc, unsigned& nx) {
    const unsigned G = gridDim.x * gridDim.y * gridDim.z;
    unsigned sum, cnt, mine, sp = 0u;
    for (;;) {
        sum = 0u; cnt = 0u; mine = 0u;
#pragma unroll
        for (unsigned j = 0; j < 16; ++j) { const unsigned c = xb_ld(&bar[XB_XCNT(j)]); sum += c; cnt += (c > 0u) ? 1u : 0u; mine = (j == x) ? c : mine; }
        if (sum == G) break;
        __builtin_amdgcn_s_sleep(1);
        if ((++sp & 255u) == 0u) { if (xb_ld(&bar[XB_TMO])) break; if (sp > XB_SPIN_CAP) { atomicAdd(&bar[XB_TMO], 1u); break; } }
    }
    nloc = mine > 0u ? mine : 1u; nx = cnt > 0u ? cnt : 1u;
}

__device__ __forceinline__ void xcd_barrier(const XcdBarrier& b) {
    asm volatile("s_waitcnt vmcnt(0)" ::: "memory");
    __syncthreads();
    if (threadIdx.x == 0) {
        unsigned* bar = b.bar;
        __builtin_amdgcn_s_waitcnt(0);
        unsigned nloc = b.st[0], nx = b.st[1];
        if (nloc == 0u) { xcd_barrier_complete(bar, b.x, nloc, nx); b.st[0] = nloc; b.st[1] = nx; }
        const unsigned old = xb_add(&bar[XB_XSUB(b.x)], 1u);
        const unsigned gen = old / nloc;
        if (old + 1u == (gen + 1u) * nloc) {
            __builtin_amdgcn_fence(__ATOMIC_RELEASE, "agent");
            asm volatile("s_waitcnt vmcnt(0)" ::: "memory");
            const unsigned og = xb_add(&bar[XB_TOP], 1u);
            const unsigned tg = og / nx;
            if (og + 1u == (tg + 1u) * nx) xb_add(&bar[XB_TOPGEN], 1u);
            else XB_SPIN(xb_ld(&bar[XB_TOPGEN]) == tg, bar);
            __builtin_amdgcn_fence(__ATOMIC_ACQUIRE, "agent");
            xb_add(&bar[XB_XGEN(b.x)], 1u);
            asm volatile("s_waitcnt vmcnt(0)" ::: "memory");
        } else {
            XB_SPIN(xb_ld(&bar[XB_XGEN(b.x)]) == gen, bar);
            __builtin_amdgcn_fence(__ATOMIC_ACQUIRE, "agent");
            asm volatile("s_waitcnt vmcnt(0)" ::: "memory");
        }
    }
    __syncthreads();
}
#ifndef MK_N_LAUNCHES
#define MK_N_LAUNCHES 1
#endif
constexpr int N_PHASES = 11;
#ifndef PROBE_PH
#define PROBE_PH (-1)
#define PROBE_REPS 1
#endif
struct Args { const float* in[19]; float* out; unsigned char* ws; int ph_lo, ph_hi; };
__global__ void __launch_bounds__(NTHR, 2) hybrid_fwd(Args a) {
    extern __shared__ __attribute__((aligned(16))) unsigned char lds_raw[];
    LAS unsigned char* lds = (LAS unsigned char*)lds_raw;
    cg::grid_group grid = cg::this_grid();
    if (a.ph_lo < 0) grid.sync();
    volatile LAS unsigned* misc = (volatile LAS unsigned*)(lds + LDS_BYTES - 64);
    if (threadIdx.x < 2) misc[threadIdx.x] = 0u;
    __syncthreads();
    XcdBarrier bar = xcd_barrier_post((unsigned*)a.ws, misc);
    Frame F;
    F.x_p = a.in[0]; F.x_s = a.in[1]; F.st_ret = a.in[2]; F.st_gla = a.in[3]; F.c_p = a.in[4]; F.c_s = a.in[5]; F.w_ada = a.in[6]; F.b_ada = a.in[7]; F.mix_norm = a.in[8];
    F.w_in = a.in[9]; F.w_gk = a.in[10]; F.b_gk = a.in[11]; F.ret_norm = a.in[12]; F.gla_norm = a.in[13]; F.w_out = a.in[14]; F.ffn_norm = a.in[15]; F.w_gu = a.in[16];
    F.w_dn = a.in[17]; F.fin_norm = a.in[18]; F.out = a.out; F.ws = a.ws;
    F.WIN = (bf16*)(a.ws + WS_WIN); F.WOUT = (bf16*)(a.ws + WS_WOUT); F.WGU = (bf16*)(a.ws + WS_WGU); F.WDN = (bf16*)(a.ws + WS_WDN);
    F.H = (bf16*)(a.ws + WS_H); F.MIX = (bf16*)(a.ws + WS_MIX); F.PROJ = (bf16*)(a.ws + WS_PROJ); F.HID = (bf16*)(a.ws + WS_HID);
    F.SRET = (bf16*)(a.ws + WS_SRET); F.SGLA = (bf16*)(a.ws + WS_SGLA);
    F.UR = a.out; F.UG = a.out + (size_t)512 * 16384; F.BL = (float*)(a.ws + WS_BL);
    F.MOD = (float*)(a.ws + WS_MOD); F.RC = (float*)(a.ws + WS_ROPE); F.RS = F.RC + ROPE_ROWS * 64;
    const int G = gridDim.x, bx = blockIdx.x, lo = a.ph_lo, hi = a.ph_hi;
#define IN(k) (lo <= (k) && (k) < hi)
#define SEAM(k) do { if (IN(k) && IN((k) + 1)) xcd_barrier(bar); } while (0)
#define RUN(k, BODY) do { if (IN(k)) { for (int rep = 0; rep < ((PROBE_PH == (k)) ? PROBE_REPS : 1); ++rep) { if (rep) xcd_barrier(bar); BODY; } } SEAM(k); } while (0)
#define PH0 p0_prologue(F, lds)
#define PH1 norm_phase<true>(F.x_p, F.x_s, F.mix_norm, F.MOD, 0, 1, F.H, nullptr, nullptr, 0, nullptr)
#define PH2 { pg8::Gemm g{F.H, F.WIN, NTOK, NPROJ, DM}; pg8::StaticOrder S; S.init(NTOK, NPROJ, G, bx, DM); pg8::EpiProj E{F.PROJ, F.RC, F.RS}; \
        pg8::gemm_phase<pg8::EpiProj, pg8::StaticOrder, true, true>(lds, g, S, E); }
#define PH3 { for (int it = bx; it < 1536; it += G) { if (it < 512) ret_u_item(F, it, lds); else gla_u_item(F, it - 512, lds); } \
        for (int j = bx; j < 1024; j += G) { if (j < 512) sample_item<128, false>(F, j >> 2, j & 3, lds); else sample_item<64, true>(F, (j - 512) >> 2, j & 3, lds); } }
#define PHSCAN scan_phase(F)
#define PH4 { for (int it = bx; it < 1536; it += G) { if (it < 512) ret_pass2(F, it, lds); else gla_pass2(F, it - 512, lds); } }
#define PH5 { pg8::Gemm g{F.MIX, F.WOUT, NTOK, DM, DM}; pg8::TailSplitOrder S; S.init(G, bx, DM, 8); pg8::EpiRes E{F.x_p, F.x_s, F.out, F.MOD + 2 * DM, (float*)(a.ws + WS_PART1)}; \
        pg8::gemm_phase<pg8::EpiRes, pg8::TailSplitOrder, true, true>(lds, g, S, E); }
#define PH6 norm_phase<true>(F.out, F.x_s, F.ffn_norm, F.MOD, 3, 4, F.H, F.out, (const float*)(a.ws + WS_PART1), 8, F.MOD + 2 * DM)
#define PH7 { pg8::Gemm g{F.H, F.WGU, NTOK, 2 * DFF, DM}; pg8::StaticOrder S; S.init(NTOK, 2 * DFF, G, bx, DM); pg8::EpiSwiGLU E{F.HID}; \
        pg8::gemm_phase<pg8::EpiSwiGLU, pg8::StaticOrder, true, true>(lds, g, S, E); }
#define PH8 { pg8::Gemm g{F.HID, F.WDN, NTOK, DM, DFF}; pg8::TailSplitOrder S; S.init(G, bx, DFF, 11); pg8::EpiRes E{F.out, F.out + (size_t)NTOKP * DM, F.out, F.MOD + 5 * DM, (float*)(a.ws + WS_PART2)}; \
        pg8::gemm_phase<pg8::EpiRes, pg8::TailSplitOrder, true, true>(lds, g, S, E); }
#define PH9 norm_phase<false>(F.out, F.out + (size_t)NTOKP * DM, F.fin_norm, nullptr, 0, 0, nullptr, F.out, (const float*)(a.ws + WS_PART2), 11, F.MOD + 5 * DM)
    RUN(0, PH0); RUN(1, PH1);
#ifdef PROBE_SYNCS
    for (int i = 0; i < PROBE_SYNCS; ++i) xcd_barrier(bar);
#endif
    RUN(2, PH2); RUN(3, PH3); RUN(4, PHSCAN); RUN(5, PH4); RUN(6, PH5); RUN(7, PH6); RUN(8, PH7); RUN(9, PH8); RUN(10, PH9);
}

extern "C" void kernel_launch(void* const* d_in, const int* in_sizes, int n_in, void* d_out, int out_size, void* d_ws, size_t ws_size, hipStream_t stream) {
    static int grid = 0;
    if (grid == 0) {
        int dev = 0, cus = 0, per_cu = 0;
        if (n_in != 19 || ws_size < WS_END) { fprintf(stderr, "kernel_launch: unexpected n_in %d / ws %zu\n", n_in, ws_size); grid = -1; return; }
        (void)hipGetDevice(&dev);
        (void)hipDeviceGetAttribute(&cus, hipDeviceAttributeMultiprocessorCount, dev);
        (void)hipFuncSetAttribute((const void*)hybrid_fwd, hipFuncAttributeMaxDynamicSharedMemorySize, LDS_BYTES);
        (void)hipOccupancyMaxActiveBlocksPerMultiprocessor(&per_cu, (const void*)hybrid_fwd, NTHR, LDS_BYTES);
        if (per_cu < 1) { fprintf(stderr, "kernel_launch: occupancy query reports %d blocks per CU\n", per_cu); grid = -1; return; }
        grid = cus;
        if (grid > 256) grid = 256;
    }
    if (grid < 0) return;
    (void)hipMemsetAsync(d_ws, 0, XCD_BAR_WORDS * 4, stream);
    Args a{};
    for (int i = 0; i < 19; ++i) a.in[i] = (const float*)d_in[i];
    a.out = (float*)d_out; a.ws = (unsigned char*)d_ws;
#if MK_N_LAUNCHES == 1
    a.ph_lo = 0; a.ph_hi = N_PHASES;
    void* args[] = {&a};
    hipError_t e = hipLaunchCooperativeKernel((void*)hybrid_fwd, dim3(grid), dim3(NTHR), args, LDS_BYTES, stream);
    if (e != hipSuccess) fprintf(stderr, "cooperative launch failed: %s (grid %d)\n", hipGetErrorString(e), grid);
#else
    for (int p = 0; p < N_PHASES; ++p) { a.ph_lo = p; a.ph_hi = p + 1; hipLaunchKernelGGL(hybrid_fwd, dim3(grid), dim3(NTHR), LDS_BYTES, stream, a); }
#endif
}
```

```cpp
#include <hip/hip_runtime.h>
#include <hip/hip_cooperative_groups.h>
#include <cstdio>
#include <cstdint>
namespace cg = cooperative_groups;

constexpr int NTOKP = 16384, NTOK = 17408, DM = 1024, NPROJ = 3840, DFF = 2816, MODW = 6144;
__device__ __forceinline__ int row_seq(int row) { return row < NTOKP ? (row >> 11) : 8 + ((row - NTOKP) >> 3); }
__device__ __forceinline__ int row_rope(int row) { return row < NTOKP ? (row & 2047) : 2048 + ((row - NTOKP) & 7); }
namespace pg8 {
#define PG8_LAS __attribute__((address_space(3)))
typedef unsigned short bf16_t;
typedef short bf16x8 __attribute__((ext_vector_type(8)));
typedef float f32x4 __attribute__((ext_vector_type(4)));
typedef unsigned u32x4 __attribute__((ext_vector_type(4)));
constexpr int BM = 256, BK = 64, HALF = 128, HTB = HALF * BK * 2  , STAGE_BYTES = 8 * HTB, NXCD = 8, WGM = 8;

__host__ __device__ __forceinline__ int lds_byte(int r, int c) { const int st = (r >> 4) * 2 + (c >> 5), rr = r & 15, cc = c & 31, ob = rr * 64 + cc * 2; return st * 1024 + (ob ^ (((ob >> 9) & 1) << 5)); }
__host__ __device__ __forceinline__ void stage_rc(int b, int& R, int& C) { const int st = b / 1024, sb = b % 1024, swz = sb ^ (((sb >> 9) & 1) << 5); R = (st >> 1) * 16 + swz / 64; C = (st & 1) * 32 + (swz % 64) / 2; }
__host__ __device__ __forceinline__ int perm32(int rho) { const int n = rho >> 4, i = rho & 15; return 8 * (i >> 2) + 4 * n + (i & 3); }

struct Unit { int pm, pn, k0, nt; };
struct Gemm { const bf16_t* A; const bf16_t* Bt; int M, N, K; };

struct StaticOrder {
    int nM, nN, nwg, G, c, ntk;
    __host__ __device__ void init(int M, int N, int G_, int c_, int K_) { nM = M / BM; nN = N / BM; nwg = nM * nN; G = G_; c = c_; ntk = K_ / BK; }
    __host__ __device__ bool next(int i, Unit& u) const {
        const long L = (long)i * G + c; if (L >= nwg) return false;
        int wgid = (int)L; { const int q = nwg / NXCD, r = nwg % NXCD, xcd = wgid % NXCD, off = wgid / NXCD; wgid = (xcd < r ? xcd * (q + 1) : r * (q + 1) + (xcd - r) * q) + off; }
        const int nig = WGM * nN, gid = wgid / nig, fm = gid * WGM, gsz = (nM - fm) < WGM ? (nM - fm) : WGM;
        u.pm = fm + ((wgid % nig) % gsz); u.pn = (wgid % nig) / gsz; u.k0 = 0; u.nt = ntk; return true;
    }
    __device__ __forceinline__ void a_ready(const Unit&) const {}
    __device__ __forceinline__ void done(const Unit&) const {}
};

__device__ __forceinline__ unsigned cvt_pk_bf16(float lo, float hi) { unsigned r; asm volatile("v_cvt_pk_bf16_f32 %0, %1, %2" : "=v"(r) : "v"(lo), "v"(hi)); return r; }
struct EpiProj {
    static constexpr bool PERM = true, AFTER_DRAIN = false;
    bf16_t* O; const float* cs; const float* sn;
    __device__ __forceinline__ void operator()(const f32x4 (&acc)[2][2][4][2], const Unit& u, int wr, int wc, int fr, int fq) const {
        const int row0 = u.pm * BM + wr * 64 + fr;
        if (u.pn < 4) {
            const int hl = wc >> 1, f0 = 32 * (wc & 1) + 8 * fq;
            const float scale = (u.pn >= 2) ? 0.08838834764831845f : 1.0f;
            const int colbase = u.pn * 256 + hl * 128 + f0;
#pragma unroll
            for (int ai = 0; ai < 2; ++ai)
#pragma unroll
                for (int m = 0; m < 4; ++m) {
                    const int row = row0 + ai * HALF + m * 16; const int pr = row_rope(row);
                    const f32x4 c0 = *(const f32x4*)(cs + pr * 64 + f0), c1 = *(const f32x4*)(cs + pr * 64 + f0 + 4);
                    const f32x4 s0 = *(const f32x4*)(sn + pr * 64 + f0), s1 = *(const f32x4*)(sn + pr * 64 + f0 + 4);
                    const f32x4 x10 = acc[ai][0][m][0], x11 = acc[ai][0][m][1], x20 = acc[ai][1][m][0], x21 = acc[ai][1][m][1];
                    const f32x4 a0 = (x10 * c0 - x20 * s0) * scale, a1 = (x11 * c1 - x21 * s1) * scale;
                    const f32x4 b0 = (x10 * s0 + x20 * c0) * scale, b1 = (x11 * s1 + x21 * c1) * scale;
                    bf16_t* rowp = O + (size_t)row * NPROJ + colbase;
                    u32x4 w; w.x = cvt_pk_bf16(a0[0], a0[1]); w.y = cvt_pk_bf16(a0[2], a0[3]); w.z = cvt_pk_bf16(a1[0], a1[1]); w.w = cvt_pk_bf16(a1[2], a1[3]);
                    *(u32x4*)rowp = w;
                    w.x = cvt_pk_bf16(b0[0], b0[1]); w.y = cvt_pk_bf16(b0[2], b0[3]); w.z = cvt_pk_bf16(b1[0], b1[1]); w.w = cvt_pk_bf16(b1[2], b1[3]);
                    *(u32x4*)(rowp + 64) = w;
                }
        } else {
            const float sc = (u.pn == 8) ? 0.125f : 1.0f;
            const int col0 = u.pn * BM + wc * 32 + 8 * fq;
#pragma unroll
            for (int ai = 0; ai < 2; ++ai)
#pragma unroll
                for (int m = 0; m < 4; ++m) { bf16_t* rowp = O + (size_t)(row0 + ai * HALF + m * 16) * NPROJ + col0;
#pragma unroll
                    for (int bj = 0; bj < 2; ++bj) { const f32x4 v0 = acc[ai][bj][m][0] * sc, v1 = acc[ai][bj][m][1] * sc;
                        u32x4 w; w.x = cvt_pk_bf16(v0[0], v0[1]); w.y = cvt_pk_bf16(v0[2], v0[3]); w.z = cvt_pk_bf16(v1[0], v1[1]); w.w = cvt_pk_bf16(v1[2], v1[3]);
                        *(u32x4*)(rowp + bj * HALF) = w; } }
        }
    }
};
struct TailSplitOrder {
    StaticOrder full; int G, c, KS, ntp;
    __host__ __device__ void init(int G_, int c_, int K_, int KS_) { full.init(16384, 1024, G_, c_, K_); G = G_; c = c_; KS = KS_; ntp = K_ / BK / KS_; }
    __host__ __device__ bool next(int i, Unit& u) const {
        const long L = (long)i * G + c;
        if (L < 256) { StaticOrder f = full; f.G = 1; f.c = (int)L; return f.next(0, u); }
        const int s = (int)(L - 256); if (s >= 16 * KS) return false;
        const int tu = s / KS, part = s % KS; u.pm = 64 + (tu >> 2); u.pn = tu & 3; u.k0 = part * ntp * BK; u.nt = ntp; return true;
    }
    __device__ __forceinline__ void a_ready(const Unit&) const {}
    __device__ __forceinline__ void done(const Unit&) const {}
};
struct EpiRes {
    static constexpr bool PERM = false, AFTER_DRAIN = false;
    const float* base_p; const float* base_s; float* out; const float* gate; float* parts;
    __device__ __forceinline__ void operator()(const f32x4 (&acc)[2][2][4][2], const Unit& u, int wr, int wc, int fr, int fq) const {
        const int row0 = u.pm * BM + wr * 64 + fr, col0 = u.pn * BM + wc * 32 + 4 * fq;
#pragma unroll
        for (int ai = 0; ai < 2; ++ai)
#pragma unroll
            for (int m = 0; m < 4; ++m) {
                const int row = row0 + ai * HALF + m * 16;
                const float* brow = row < NTOKP ? base_p + (size_t)row * DM : base_s + (size_t)(row - NTOKP) * DM;
                const float* g = gate + (size_t)row_seq(row) * MODW;
                float* orow = out + (size_t)row * DM;
#pragma unroll
                for (int bj = 0; bj < 2; ++bj)
#pragma unroll
                    for (int n = 0; n < 2; ++n) { const int c = col0 + bj * HALF + n * 16;
                        if (u.pm >= 64) *(f32x4*)(parts + (size_t)(u.k0 / (u.nt * BK)) * 1048576 + (size_t)(row - NTOKP) * DM + c) = acc[ai][bj][m][n];
                        else { const f32x4 bv = *(const f32x4*)(brow + c), gv = *(const f32x4*)(g + c); *(f32x4*)(orow + c) = bv + gv * acc[ai][bj][m][n]; } }
            }
    }
};
struct EpiSwiGLU {
    static constexpr bool PERM = true, AFTER_DRAIN = false;
    bf16_t* O;
    __device__ __forceinline__ void operator()(const f32x4 (&acc)[2][2][4][2], const Unit& u, int wr, int wc, int fr, int fq) const {
        const int row0 = u.pm * BM + wr * 64 + fr, col0 = u.pn * HALF + wc * 32 + 8 * fq;
#pragma unroll
        for (int ai = 0; ai < 2; ++ai)
#pragma unroll
            for (int m = 0; m < 4; ++m) {
                float v[8];
#pragma unroll
                for (int n = 0; n < 2; ++n)
#pragma unroll
                    for (int e = 0; e < 4; ++e) { const float a = acc[ai][0][m][n][e], b = acc[ai][1][m][n][e];
                        v[n * 4 + e] = a * __builtin_amdgcn_rcpf(1.0f + __expf(-a)) * b; }
                u32x4 w; w.x = cvt_pk_bf16(v[0], v[1]); w.y = cvt_pk_bf16(v[2], v[3]); w.z = cvt_pk_bf16(v[4], v[5]); w.w = cvt_pk_bf16(v[6], v[7]);
                *(u32x4*)(O + (size_t)(row0 + ai * HALF + m * 16) * DFF + col0) = w;
            }
    }
};

template <class Epi, class Sched, bool ALIGN_EPI = false, bool SP2 = false>
__device__ __forceinline__ void gemm_phase(PG8_LAS unsigned char* lds, const Gemm g, const Sched& S, const Epi& E) {
    const int tid = threadIdx.x, wid = __builtin_amdgcn_readfirstlane(tid >> 6), lane = tid & 63, wr = wid >> 2, wc = wid & 3, fr = lane & 15, fq = lane >> 4;
    const int K = g.K;
    unsigned voffA[2], voffB[2];
#pragma unroll
    for (int i = 0; i < 2; ++i) { int R, C; stage_rc(tid * 16 + i * 8192, R, C); const int Rb = Epi::PERM ? ((R & ~31) + perm32(R & 31)) : R;
        voffA[i] = (unsigned)(R * K + C) * 2u; voffB[i] = (unsigned)(Rb * K + C) * 2u; }
    const size_t kstep = (size_t)(BK * 2);
    const size_t hstep = (size_t)HALF * K * 2;
    const size_t tstep = 2 * hstep;
    const unsigned ldsw = (unsigned)wid * 1024u;
    const int aoff = lds_byte(wr * 64 + fr, fq * 8), boff = lds_byte(wc * 32 + fr, fq * 8);
#define PG8_SA(b, h) (((b) * 2 + (h)) * HTB)
#define PG8_SB(b, h) ((4 + (b) * 2 + (h)) * HTB)
#define PG8_STAGE(bufoff, gbase, voff) do { _Pragma("unroll") for (int _i = 0; _i < 2; ++_i) \
        __builtin_amdgcn_global_load_lds((const unsigned*)((const char*)(gbase) + (voff)[_i]), (PG8_LAS unsigned*)(lds + (bufoff) + ldsw + _i * 8192), 16, 0, 0); } while (0)
#define PG8_LDA(dst, b, h) do { _Pragma("unroll") for (int m = 0; m < 4; ++m) _Pragma("unroll") for (int k = 0; k < 2; ++k) dst[m][k] = *(const PG8_LAS bf16x8*)(lds + PG8_SA(b, h) + aoff + m * 2048 + k * 1024); } while (0)
#define PG8_LDB(dst, b, h) do { _Pragma("unroll") for (int n = 0; n < 2; ++n) _Pragma("unroll") for (int k = 0; k < 2; ++k) dst[n][k] = *(const PG8_LAS bf16x8*)(lds + PG8_SB(b, h) + boff + n * 2048 + k * 1024); } while (0)
#define PG8_MMA(ai, bj, At, Bt) do { __builtin_amdgcn_s_setprio(1); _Pragma("unroll") for (int m = 0; m < 4; ++m) _Pragma("unroll") for (int n = 0; n < 2; ++n) _Pragma("unroll") for (int k = 0; k < 2; ++k) \
        acc[ai][bj][m][n] = __builtin_amdgcn_mfma_f32_16x16x32_bf16(Bt[n][k], At[m][k], acc[ai][bj][m][n], 0, 0, 0); __builtin_amdgcn_s_setprio(0); } while (0)
#define PG8_WAIT_V(n) asm volatile("s_waitcnt vmcnt(" #n ")" ::: "memory")
#define PG8_WAIT_L(n) asm volatile("s_waitcnt lgkmcnt(" #n ")" ::: "memory")
#define PG8_BAR __builtin_amdgcn_s_barrier()
#define PG8_SCHED __builtin_amdgcn_sched_barrier(0)
    Unit cur, nxt; int ui = 0;
    if (!S.next(0, cur)) return;
    f32x4 acc[2][2][4][2];
#pragma unroll
    for (int a = 0; a < 2; ++a)
#pragma unroll
        for (int b = 0; b < 2; ++b)
#pragma unroll
            for (int m = 0; m < 4; ++m)
#pragma unroll
                for (int n = 0; n < 2; ++n) acc[a][b][m][n] = (f32x4){0.f, 0.f, 0.f, 0.f};
    bf16x8 At[4][2], B0[2][2], B1[2][2];
    const char* cA = (const char*)g.A + (size_t)cur.pm * tstep + (size_t)cur.k0 * 2; const char* cB = (const char*)g.Bt + (size_t)cur.pn * tstep + (size_t)cur.k0 * 2; int nt = cur.nt;
    S.a_ready(cur);
    if constexpr (SP2) {
        PG8_STAGE(PG8_SB(0, 0), cB, voffB); PG8_STAGE(PG8_SB(0, 1), cB + hstep, voffB); PG8_STAGE(PG8_SA(0, 0), cA, voffA); PG8_STAGE(PG8_SA(0, 1), cA + hstep, voffA);
        if (wr == 1) PG8_BAR;
        PG8_WAIT_V(2); PG8_BAR;
        PG8_STAGE(PG8_SB(1, 0), cB + kstep, voffB); PG8_STAGE(PG8_SA(1, 0), cA + kstep, voffA); PG8_STAGE(PG8_SB(1, 1), cB + hstep + kstep, voffB);
        PG8_WAIT_V(6); PG8_BAR;
    } else {
        PG8_STAGE(PG8_SB(0, 0), cB, voffB); PG8_STAGE(PG8_SA(0, 0), cA, voffA); PG8_STAGE(PG8_SB(0, 1), cB + hstep, voffB); PG8_STAGE(PG8_SA(0, 1), cA + hstep, voffA);
        if (wr == 1) PG8_BAR;
        PG8_WAIT_V(4); PG8_BAR;
        PG8_STAGE(PG8_SB(1, 0), cB + kstep, voffB); PG8_STAGE(PG8_SA(1, 0), cA + kstep, voffA); PG8_STAGE(PG8_SB(1, 1), cB + hstep + kstep, voffB);
        PG8_WAIT_V(6); PG8_BAR;
    }
    for (;;) {
        const bool has_next = S.next(ui + 1, nxt);
        const char* nA = has_next ? (const char*)g.A + (size_t)nxt.pm * tstep + (size_t)nxt.k0 * 2 : cA; const char* nB = has_next ? (const char*)g.Bt + (size_t)nxt.pn * tstep + (size_t)nxt.k0 * 2 : cB;
        for (int t = 0; t < nt; t += 2) {
            const bool last = (t == nt - 2);
            const char* a1 = cA + (size_t)(t + 1) * kstep;
            const char* a2 = last ? nA : cA + (size_t)(t + 2) * kstep; const char* b2 = last ? nB : cB + (size_t)(t + 2) * kstep;
            const char* a3 = a2 + kstep; const char* b3 = b2 + kstep;
            if (last && has_next) S.a_ready(nxt);
            if constexpr (SP2) {
            PG8_LDB(B0, 0, 0); PG8_LDB(B1, 0, 1); PG8_SCHED; PG8_LDA(At, 0, 0); PG8_STAGE(PG8_SA(1, 1), a1 + hstep, voffA);
            PG8_WAIT_V(8); PG8_WAIT_L(0); PG8_BAR; PG8_MMA(0, 0, At, B0); PG8_MMA(0, 1, At, B1); PG8_BAR; PG8_SCHED;
            PG8_LDA(At, 0, 1); PG8_STAGE(PG8_SB(0, 0), b2, voffB); PG8_STAGE(PG8_SB(0, 1), b2 + hstep, voffB); PG8_STAGE(PG8_SA(0, 0), a2, voffA);
            PG8_WAIT_V(8); PG8_WAIT_L(0); PG8_BAR; PG8_MMA(1, 0, At, B0); PG8_MMA(1, 1, At, B1); PG8_BAR; PG8_SCHED;
            PG8_LDB(B0, 1, 0); PG8_LDB(B1, 1, 1); PG8_SCHED; PG8_LDA(At, 1, 0); PG8_STAGE(PG8_SA(0, 1), a2 + hstep, voffA);
            PG8_WAIT_V(8); PG8_WAIT_L(0); PG8_BAR; PG8_MMA(0, 0, At, B0); PG8_MMA(0, 1, At, B1); PG8_BAR; PG8_SCHED;
            PG8_LDA(At, 1, 1); PG8_STAGE(PG8_SB(1, 0), b3, voffB); PG8_STAGE(PG8_SB(1, 1), b3 + hstep, voffB); PG8_STAGE(PG8_SA(1, 0), a3, voffA);
            PG8_WAIT_V(8); PG8_WAIT_L(0); PG8_BAR; PG8_MMA(1, 0, At, B0); PG8_MMA(1, 1, At, B1); PG8_BAR; PG8_SCHED;
            } else {
            PG8_LDB(B0, 0, 0); PG8_SCHED; PG8_LDA(At, 0, 0); PG8_STAGE(PG8_SA(1, 1), a1 + hstep, voffA);
            PG8_WAIT_L(8); PG8_BAR; PG8_WAIT_L(0); PG8_MMA(0, 0, At, B0); PG8_BAR; PG8_SCHED;
            PG8_LDB(B1, 0, 1); PG8_STAGE(PG8_SB(0, 0), b2, voffB);
            PG8_BAR; PG8_WAIT_L(0); PG8_MMA(0, 1, At, B1); PG8_BAR;
            PG8_LDA(At, 0, 1); PG8_STAGE(PG8_SA(0, 0), a2, voffA);
            PG8_BAR; PG8_WAIT_L(0); PG8_MMA(1, 0, At, B0); PG8_BAR; PG8_SCHED;
            PG8_STAGE(PG8_SB(0, 1), b2 + hstep, voffB);
            PG8_WAIT_V(6); PG8_BAR; PG8_MMA(1, 1, At, B1); PG8_BAR;
            PG8_LDB(B0, 1, 0); PG8_SCHED; PG8_LDA(At, 1, 0); PG8_STAGE(PG8_SA(0, 1), a2 + hstep, voffA);
            PG8_WAIT_L(8); PG8_BAR; PG8_WAIT_L(0); PG8_MMA(0, 0, At, B0); PG8_BAR; PG8_SCHED;
            PG8_LDB(B1, 1, 1); PG8_STAGE(PG8_SB(1, 0), b3, voffB);
            PG8_BAR; PG8_WAIT_L(0); PG8_MMA(0, 1, At, B1); PG8_BAR;
            PG8_LDA(At, 1, 1); PG8_STAGE(PG8_SA(1, 0), a3, voffA);
            PG8_BAR; PG8_WAIT_L(0); PG8_MMA(1, 0, At, B0); PG8_BAR; PG8_SCHED;
            PG8_STAGE(PG8_SB(1, 1), b3 + hstep, voffB);
            PG8_WAIT_V(6); PG8_BAR; PG8_MMA(1, 1, At, B1); PG8_BAR;
            }
        }
        if constexpr (ALIGN_EPI) { if (wr == 0) PG8_BAR; }
        if constexpr (!Epi::AFTER_DRAIN) { E(acc, cur, wr, wc, fr, fq); S.done(cur); }
        if (!has_next) break;
#pragma unroll
        for (int a = 0; a < 2; ++a)
#pragma unroll
            for (int b = 0; b < 2; ++b)
#pragma unroll
                for (int m = 0; m < 4; ++m)
#pragma unroll
                    for (int n = 0; n < 2; ++n) acc[a][b][m][n] = (f32x4){0.f, 0.f, 0.f, 0.f};
        cur = nxt; cA = nA; cB = nB; nt = cur.nt; ++ui;
        if constexpr (ALIGN_EPI) { if (wr == 1) PG8_BAR; }
    }
    PG8_WAIT_V(0);
    if constexpr (!ALIGN_EPI) { if (wr == 0) PG8_BAR; }
    PG8_BAR;
    if constexpr (Epi::AFTER_DRAIN) { E.fused(acc, cur, wr, wc, fr, fq, lds, wid, lane); S.done(cur); }
#undef PG8_SA
#undef PG8_SB
#undef PG8_STAGE
#undef PG8_LDA
#undef PG8_LDB
#undef PG8_MMA
#undef PG8_WAIT_V
#undef PG8_WAIT_L
#undef PG8_BAR
#undef PG8_SCHED
}
}
#define LAS __attribute__((address_space(3)))
typedef unsigned short bf16;
typedef unsigned v4u __attribute__((ext_vector_type(4)));
typedef unsigned v2u __attribute__((ext_vector_type(2)));
typedef float f32x4 __attribute__((ext_vector_type(4)));
typedef short bf16x8 __attribute__((ext_vector_type(8)));
constexpr int NTHR = 512;
constexpr int LDS_BYTES = 147456;
constexpr size_t MiB = 1u << 20;
constexpr size_t WS_WIN = 1 * MiB, WS_WOUT = 9 * MiB, WS_WGU = 11 * MiB, WS_WDN = 22 * MiB, WS_MOD = 28 * MiB, WS_ROPE = 32 * MiB;
constexpr size_t WS_H = 34 * MiB, WS_MIX = 68 * MiB, WS_PROJ = 102 * MiB, WS_END = 230 * MiB;
constexpr size_t WS_SRET = WS_H, WS_SGLA = WS_H + 16 * MiB, WS_HID = WS_PROJ;
constexpr int ROPE_ROWS = 2056;
constexpr size_t WS_PART1 = WS_PROJ + 94 * MiB;
constexpr size_t WS_PART2 = WS_H;
constexpr size_t WS_BL = 31 * MiB + 256 * 1024;
constexpr int C_QR = 0, C_KR = 512, C_VR = 1024, C_GR = 1536, C_QG = 2048, C_KG = 2304, C_VG = 2560, C_GG = 3072, C_LR = 3584;
constexpr size_t O_Y = 0, O_SRP = (size_t)NTOK * DM, O_SGP = O_SRP + 8 * 4 * 128 * 128, O_SRS = O_SGP + 8 * 4 * 64 * 128, O_SGS = O_SRS + (size_t)128 * 4 * 128 * 128;

__device__ __forceinline__ float bf2f(unsigned h) { return __uint_as_float(h << 16); }
__device__ __forceinline__ unsigned pk2(float lo, float hi) { return pg8::cvt_pk_bf16(lo, hi); }
__device__ __forceinline__ bf16 f2bf(float f) { unsigned u = __float_as_uint(f); return (bf16)((u + 0x7fffu + ((u >> 16) & 1u)) >> 16); }
__device__ __forceinline__ float wave_sum(float v) {
#pragma unroll
    for (int o = 32; o >= 1; o >>= 1) v += __shfl_xor(v, o);
    return v;
}
__device__ __forceinline__ float silu_f(float a) { return a * __builtin_amdgcn_rcpf(1.0f + __expf(-a)); }
__device__ __forceinline__ float logsig16(float z) { return (fminf(z, 0.f) - __logf(1.0f + __expf(-fabsf(z)))) * 0.0625f; }
__device__ __forceinline__ bf16x8 frag(const LAS bf16* base, int row, int kofs, int ls) { return *(const LAS bf16x8*)(base + row * ls + kofs); }
#define MFMA16(a, b, c) __builtin_amdgcn_mfma_f32_16x16x32_bf16((a), (b), (c), 0, 0, 0)

template <int R, int C8> __device__ __forceinline__ void tile_g2l(const bf16* g, size_t gp, LAS bf16* l, int ls) {
    for (int idx = threadIdx.x; idx < R * C8; idx += NTHR) { const int r = idx / C8, c = idx % C8;
        const v4u v = *(const v4u*)(g + (size_t)r * gp + c * 8); *(LAS v4u*)(l + r * ls + c * 8) = v; }
}
template <int J, int V8> __device__ __forceinline__ void tile_g2l_T(const bf16* g, size_t gp, LAS bf16* l, int ls) {
    for (int idx = threadIdx.x; idx < V8 * (J / 2); idx += NTHR) { const int v8 = idx / (J / 2), jp = idx % (J / 2);
        const v4u a = *(const v4u*)(g + (size_t)(2 * jp) * gp + v8 * 8), b = *(const v4u*)(g + (size_t)(2 * jp + 1) * gp + v8 * 8);
#pragma unroll
        for (int e = 0; e < 4; ++e) {
            *(LAS unsigned*)(l + (v8 * 8 + 2 * e) * ls + 2 * jp) = (a[e] & 0xffffu) | (b[e] << 16);
            *(LAS unsigned*)(l + (v8 * 8 + 2 * e + 1) * ls + 2 * jp) = (a[e] >> 16) | (b[e] & 0xffff0000u);
        }
    }
}

struct Frame {
    const float *x_p, *x_s, *st_ret, *st_gla, *c_p, *c_s, *w_ada, *b_ada, *mix_norm, *w_in, *w_gk, *b_gk, *ret_norm, *gla_norm, *w_out, *ffn_norm, *w_gu, *w_dn, *fin_norm;
    float* out; unsigned char* ws;
    bf16 *WIN, *WOUT, *WGU, *WDN, *H, *MIX, *PROJ, *HID, *SRET, *SGLA; float *MOD, *RC, *RS, *UR, *UG, *BL;
};

struct TrItem { const float* src; bf16* dst; int ldw, K, valid; };
__device__ __forceinline__ TrItem tr_decode(const Frame& F, int it) {
    constexpr int N_IN = 60 * 4, N_OUT = 16 * 4, N_GU = 88 * 4;
    const float* W; bf16* WT; int ldw, K, kind, item;
    if (it < N_IN) { W = F.w_in; ldw = 3600; WT = F.WIN; K = DM; kind = 0; item = it; }
    else if (it < N_IN + N_OUT) { W = F.w_out; ldw = DM; WT = F.WOUT; K = DM; kind = 2; item = it - N_IN; }
    else if (it < N_IN + N_OUT + N_GU) { W = F.w_gu; ldw = 2 * DFF; WT = F.WGU; K = DM; kind = 1; item = it - N_IN - N_OUT; }
    else { W = F.w_dn; ldw = DM; WT = F.WDN; K = DFF; kind = 2; item = it - N_IN - N_OUT - N_GU; }
    const int nkt = K / 256, nt = item / nkt, kt = item % nkt, r0 = nt * 64;
    int src0 = r0, valid = 64;
    if (kind == 0) { if (r0 < 1024) { const int pn = r0 >> 8, within = r0 & 255, bj = within >> 7, hl = (within & 127) >> 6; src0 = pn * 256 + hl * 128 + bj * 64; }
                     else { valid = 3600 - r0; valid = valid < 0 ? 0 : (valid > 64 ? 64 : valid); } }
    else if (kind == 1) { const int pn = r0 >> 8, within = r0 & 255, bj = within >> 7, idx = within & 127; src0 = bj * DFF + pn * 128 + idx; }
    TrItem d; d.src = W + (size_t)(kt * 256) * ldw + src0; d.dst = WT + (size_t)r0 * K + kt * 256; d.ldw = ldw; d.K = K; d.valid = valid; return d;
}
__device__ __forceinline__ void tr_load(const TrItem& d, f32x4 (&v)[8]) {
    const int t = threadIdx.x, c4 = (t & 15) * 4;
#pragma unroll
    for (int i = 0; i < 8; ++i) { const int kk = (t >> 4) + 32 * i; v[i] = (f32x4){0.f, 0.f, 0.f, 0.f};
        if (c4 < d.valid) v[i] = __builtin_nontemporal_load((const f32x4*)(d.src + (size_t)kk * d.ldw + c4)); }
}
__device__ __forceinline__ void p0_transposes(const Frame& F, int first, int step, LAS float* scr) {
    constexpr int N_ALL = 60 * 4 + 16 * 4 + 88 * 4 + 16 * 11;
    const int t = threadIdx.x, c4 = (t & 15) * 4;
    f32x4 v[8];
    int it = first;
    if (it < N_ALL) { const TrItem d = tr_decode(F, it); tr_load(d, v); }
    while (it < N_ALL) {
        const TrItem d = tr_decode(F, it);
#pragma unroll
        for (int i = 0; i < 8; ++i) { const int kk = (t >> 4) + 32 * i;
            scr[(c4 + 0) * 264 + kk] = v[i][0]; scr[(c4 + 1) * 264 + kk] = v[i][1]; scr[(c4 + 2) * 264 + kk] = v[i][2]; scr[(c4 + 3) * 264 + kk] = v[i][3]; }
        __syncthreads();
        const int nx = it + step;
        if (nx < N_ALL) { const TrItem dn = tr_decode(F, nx); tr_load(dn, v); }
#pragma unroll
        for (int i = 0; i < 4; ++i) { const int c = t + NTHR * i, n = c >> 5, k8 = (c & 31) * 8;
            const f32x4 a = *(const LAS f32x4*)(scr + n * 264 + k8), b = *(const LAS f32x4*)(scr + n * 264 + k8 + 4);
            v4u w; w.x = pk2(a[0], a[1]); w.y = pk2(a[2], a[3]); w.z = pk2(b[0], b[1]); w.w = pk2(b[2], b[3]);
            *(v4u*)(d.dst + (size_t)n * d.K + k8) = w; }
        __syncthreads();
        it = nx;
    }
}
__device__ __forceinline__ void p0_mod_slab(const Frame& F, int slab, LAS float* red) {
    const int t = threadIdx.x, lane = t & 63, w = __builtin_amdgcn_readfirstlane(t >> 6), l15 = lane & 15, quad = lane >> 4;
    f32x4 acc[9][2];
#pragma unroll
    for (int rt = 0; rt < 9; ++rt) { acc[rt][0] = (f32x4){0.f, 0.f, 0.f, 0.f}; acc[rt][1] = acc[rt][0]; }
#pragma unroll 1
    for (int ks = 0; ks < 4; ++ks) {
        const int k0 = w * 128 + ks * 32 + quad * 8;
        bf16x8 bfr[2];
#pragma unroll
        for (int ct = 0; ct < 2; ++ct) { const float* wp = F.w_ada + (size_t)k0 * MODW + slab * 32 + ct * 16 + l15; v4u p;
            p.x = pk2(__builtin_nontemporal_load(wp), __builtin_nontemporal_load(wp + MODW)); p.y = pk2(__builtin_nontemporal_load(wp + 2 * MODW), __builtin_nontemporal_load(wp + 3 * MODW));
            p.z = pk2(__builtin_nontemporal_load(wp + 4 * MODW), __builtin_nontemporal_load(wp + 5 * MODW)); p.w = pk2(__builtin_nontemporal_load(wp + 6 * MODW), __builtin_nontemporal_load(wp + 7 * MODW));
            bfr[ct] = __builtin_bit_cast(bf16x8, p); }
#pragma unroll
        for (int rt = 0; rt < 9; ++rt) { const int row = rt * 16 + l15; v4u p = (v4u){0u, 0u, 0u, 0u};
            if (row < 136) { const float* cp = (row < 8 ? F.c_p + row * DM : F.c_s + (row - 8) * DM) + k0; const f32x4 x0 = *(const f32x4*)cp, x1 = *(const f32x4*)(cp + 4);
                p.x = pk2(silu_f(x0[0]), silu_f(x0[1])); p.y = pk2(silu_f(x0[2]), silu_f(x0[3])); p.z = pk2(silu_f(x1[0]), silu_f(x1[1])); p.w = pk2(silu_f(x1[2]), silu_f(x1[3])); }
            const bf16x8 afr = __builtin_bit_cast(bf16x8, p);
            acc[rt][0] = MFMA16(afr, bfr[0], acc[rt][0]); acc[rt][1] = MFMA16(afr, bfr[1], acc[rt][1]); }
    }
    for (int ww = 0; ww < 8; ++ww) {
        if (w == ww) {
#pragma unroll
            for (int rt = 0; rt < 9; ++rt)
#pragma unroll
                for (int ct = 0; ct < 2; ++ct) { LAS f32x4* p = (LAS f32x4*)(red + (rt * 2 + ct) * 256 + lane * 4); if (ww == 0) *p = acc[rt][ct]; else *p = *p + acc[rt][ct]; }
        }
        __syncthreads();
    }
    for (int i = t; i < 18 * 256; i += NTHR) { const int tile = i >> 8, ln = (i >> 2) & 63, r = i & 3, rt = tile >> 1, ct = tile & 1;
        const int row = rt * 16 + (ln >> 4) * 4 + r, col = slab * 32 + ct * 16 + (ln & 15);
        if (row < 136) F.MOD[(size_t)row * MODW + col] = red[i] + F.b_ada[col]; }
    __syncthreads();
}
__device__ __forceinline__ void p0_prologue(const Frame& F, LAS unsigned char* lds) {
    const int G = gridDim.x, bx = blockIdx.x;
    LAS float* scr = (LAS float*)lds;
    for (int idx = bx * NTHR + threadIdx.x; idx < ROPE_ROWS * 64; idx += G * NTHR) { const int p = idx >> 6, j = idx & 63; const int pos = p < 2048 ? p : 16384 + (p - 2048);
        const float inv = (float)exp2(-(double)j * (13.287712379549449 / 64.0)); const float ang = (float)pos * inv;
        double rev = (double)ang * 0.15915494309189535; rev -= __builtin_rint(rev); const float fr = (float)rev;
        F.RC[idx] = __builtin_amdgcn_cosf(fr); F.RS[idx] = __builtin_amdgcn_sinf(fr); }
    for (int s = bx; s < 192; s += G) p0_mod_slab(F, s, scr);
    p0_transposes(F, (bx + G - (192 % G)) % G, G, scr);
}
template <bool MODULATE> __device__ __forceinline__ void norm_phase(const float* xp, const float* xs, const float* gain, const float* mod, int shi, int sci, bf16* H, float* Y,
                                                                    const float* parts, int nparts, const float* gate) {
    const int lane = threadIdx.x & 63, gw = blockIdx.x * 8 + (threadIdx.x >> 6), nw = gridDim.x * 8;
    f32x4 g[4];
#pragma unroll
    for (int i = 0; i < 4; ++i) g[i] = *(const f32x4*)(gain + 4 * lane + 256 * i);
    for (int row = gw; row < NTOK; row += nw) {
        const float* x = row < NTOKP ? xp + (size_t)row * DM : xs + (size_t)(row - NTOKP) * DM;
        f32x4 v[4];
#pragma unroll
        for (int i = 0; i < 4; ++i) v[i] = *(const f32x4*)(x + 4 * lane + 256 * i);
        if (nparts > 0 && row >= NTOKP) {
            const float* gp = gate + (size_t)row_seq(row) * MODW; const float* pp = parts + (size_t)(row - NTOKP) * DM;
#pragma unroll
            for (int i = 0; i < 4; ++i) { const int c = 4 * lane + 256 * i; f32x4 s = (f32x4){0.f, 0.f, 0.f, 0.f};
                for (int p = 0; p < nparts; ++p) s += *(const f32x4*)(pp + (size_t)p * 1048576 + c);
                v[i] += *(const f32x4*)(gp + c) * s;
                if (MODULATE) *(f32x4*)(Y + (size_t)row * DM + c) = v[i]; }
        }
        float ss = 0.f;
#pragma unroll
        for (int i = 0; i < 4; ++i) ss += v[i][0] * v[i][0] + v[i][1] * v[i][1] + v[i][2] * v[i][2] + v[i][3] * v[i][3];
        ss = wave_sum(ss);
        const float rstd = rsqrtf(ss * (1.0f / DM) + 1e-6f);
        if (MODULATE) {
            const float* m = mod + (size_t)row_seq(row) * MODW;
#pragma unroll
            for (int i = 0; i < 4; ++i) { const int c = 4 * lane + 256 * i;
                const f32x4 sc = *(const f32x4*)(m + sci * DM + c), sh = *(const f32x4*)(m + shi * DM + c);
                const f32x4 o = v[i] * rstd * g[i] * (sc + 1.0f) + sh;
                v2u w; w.x = pk2(o[0], o[1]); w.y = pk2(o[2], o[3]); *(v2u*)(H + (size_t)row * DM + c) = w; }
        } else {
#pragma unroll
            for (int i = 0; i < 4; ++i) { const int c = 4 * lane + 256 * i; *(f32x4*)(Y + (size_t)row * DM + c) = v[i] * rstd * g[i]; }
        }
    }
}
typedef short s16x4 __attribute__((ext_vector_type(4)));
__device__ __forceinline__ bf16x8 frag_tr(const LAS bf16* base, int krow0, int col0, int ls, int lane) {
    const int l15 = lane & 15, quad = lane >> 4;
    const LAS bf16* a = base + (krow0 + quad * 8 + (l15 >> 2)) * ls + col0 + 4 * (l15 & 3);
    const s16x4 lo = __builtin_bit_cast(s16x4, __builtin_amdgcn_ds_read_tr16_b64_v4i16((LAS s16x4*)a));
    const s16x4 hi = __builtin_bit_cast(s16x4, __builtin_amdgcn_ds_read_tr16_b64_v4i16((LAS s16x4*)(a + 4 * ls)));
    return (bf16x8){lo[0], lo[1], lo[2], lo[3], hi[0], hi[1], hi[2], hi[3]};
}
__device__ __forceinline__ void ret_u_item(const Frame& F, int item, LAS unsigned char* lds) {
    const int b = item >> 6, h = (item >> 4) & 3, n = item & 15;
    const int t = threadIdx.x, lane = t & 63, w = __builtin_amdgcn_readfirstlane(t >> 6), l15 = lane & 15, quad = lane >> 4;
    LAS bf16* Ks = (LAS bf16*)lds; LAS bf16* Vs = Ks + 128 * 136;
    const size_t row0 = (size_t)b * 2048 + n * 128;
    const float lg2 = log1pf(-exp2f(-5.0f - (float)h)) * 1.4426950408889634f;
    tile_g2l<128, 16>(F.PROJ + row0 * NPROJ + C_KR + h * 128, NPROJ, Ks, 136);
    for (int idx = t; idx < 128 * 16; idx += NTHR) { const int j = idx >> 4, c = idx & 15;
        const v4u v = *(const v4u*)(F.PROJ + (row0 + j) * NPROJ + C_VR + h * 128 + c * 8); const float dec = __builtin_amdgcn_exp2f(lg2 * (float)(127 - j));
        v4u o;
#pragma unroll
        for (int e = 0; e < 4; ++e) o[e] = pk2(bf2f(v[e] & 0xffffu) * dec, bf2f(v[e] >> 16) * dec);
        *(LAS v4u*)(Vs + j * 136 + c * 8) = o; }
    __syncthreads();
    bf16x8 av[4];
#pragma unroll
    for (int ks = 0; ks < 4; ++ks) av[ks] = frag_tr(Vs, ks * 32, 16 * w, 136, lane);
    float* U = F.UR + (size_t)item * 16384;
#pragma unroll
    for (int dt = 0; dt < 8; ++dt) { f32x4 acc = (f32x4){0.f, 0.f, 0.f, 0.f};
#pragma unroll
        for (int ks = 0; ks < 4; ++ks) acc = MFMA16(av[ks], frag_tr(Ks, ks * 32, 16 * dt, 136, lane), acc);
#pragma unroll
        for (int r = 0; r < 4; ++r) U[(16 * w + quad * 4 + r) * 128 + 16 * dt + l15] = acc[r]; }
    __syncthreads();
}
__device__ __forceinline__ void gla_gk_cumsum(const Frame& F, int h, size_t row0, LAS float* bcum, LAS float* lrs, LAS float* tot) {
    const int t = threadIdx.x, dcol = t & 63, jg = t >> 6;
    if (t < 128) { const int j = t >> 1, hf = t & 1; const v4u v = *(const v4u*)(F.PROJ + (row0 + j) * NPROJ + C_LR + hf * 8);
#pragma unroll
        for (int e = 0; e < 4; ++e) { lrs[j * 16 + hf * 8 + 2 * e] = bf2f(v[e] & 0xffffu); lrs[j * 16 + hf * 8 + 2 * e + 1] = bf2f(v[e] >> 16); } }
    float w2[16];
#pragma unroll
    for (int r = 0; r < 16; ++r) w2[r] = F.w_gk[r * 256 + h * 64 + dcol];
    const float bias = F.b_gk[h * 64 + dcol];
    __syncthreads();
    float gl[8]; float run = 0.f;
#pragma unroll
    for (int i = 0; i < 8; ++i) { float z = bias;
#pragma unroll
        for (int r4 = 0; r4 < 4; ++r4) { const f32x4 l = *(const LAS f32x4*)(lrs + (jg * 8 + i) * 16 + r4 * 4); z += l[0] * w2[r4 * 4] + l[1] * w2[r4 * 4 + 1] + l[2] * w2[r4 * 4 + 2] + l[3] * w2[r4 * 4 + 3]; }
        run += logsig16(z); gl[i] = run; }
    tot[jg * 64 + dcol] = run;
    __syncthreads();
    float pre = 0.f;
#pragma unroll
    for (int q = 0; q < 8; ++q) { const float v = tot[q * 64 + dcol]; pre += (q < jg) ? v : 0.f; }
#pragma unroll
    for (int i = 0; i < 8; ++i) bcum[(jg * 8 + i) * 64 + dcol] = pre + gl[i];
    __syncthreads();
}
__device__ __forceinline__ void gla_u_item(const Frame& F, int item, LAS unsigned char* lds) {
    const int b = item >> 7, h = (item >> 5) & 3, n = item & 31;
    const int t = threadIdx.x, lane = t & 63, w = __builtin_amdgcn_readfirstlane(t >> 6), l15 = lane & 15, quad = lane >> 4;
    LAS bf16* Ks = (LAS bf16*)lds;
    LAS bf16* Vs = Ks + 64 * 72;
    LAS float* bcum = (LAS float*)(lds + 32768);
    LAS float* lrs = bcum + 4096;
    LAS float* tot = lrs + 1024;
    const size_t row0 = (size_t)b * 2048 + n * 64;
    tile_g2l<64, 16>(F.PROJ + row0 * NPROJ + C_VG + h * 128, NPROJ, Vs, 136);
    const int i = t >> 3, d8 = (t & 7) * 8;
    const v4u k = *(const v4u*)(F.PROJ + (row0 + i) * NPROJ + C_KG + h * 64 + d8);
    gla_gk_cumsum(F, h, row0, bcum, lrs, tot);
    { const f32x4 b0 = *(const LAS f32x4*)(bcum + i * 64 + d8), b1 = *(const LAS f32x4*)(bcum + i * 64 + d8 + 4);
      const f32x4 l0 = *(const LAS f32x4*)(bcum + 63 * 64 + d8), l1 = *(const LAS f32x4*)(bcum + 63 * 64 + d8 + 4);
      const f32x4 e0 = l0 - b0, e1 = l1 - b1; v4u ko;
      ko.x = pk2(bf2f(k.x & 0xffffu) * __expf(e0[0]), bf2f(k.x >> 16) * __expf(e0[1])); ko.y = pk2(bf2f(k.y & 0xffffu) * __expf(e0[2]), bf2f(k.y >> 16) * __expf(e0[3]));
      ko.z = pk2(bf2f(k.z & 0xffffu) * __expf(e1[0]), bf2f(k.z >> 16) * __expf(e1[1])); ko.w = pk2(bf2f(k.w & 0xffffu) * __expf(e1[2]), bf2f(k.w >> 16) * __expf(e1[3]));
      *(LAS v4u*)(Ks + i * 72 + d8) = ko; }
    if (t < 64) F.BL[(size_t)item * 64 + t] = bcum[63 * 64 + t];
    __syncthreads();
    bf16x8 av[2];
#pragma unroll
    for (int ks = 0; ks < 2; ++ks) av[ks] = frag_tr(Vs, ks * 32, 16 * w, 136, lane);
    float* U = F.UG + (size_t)item * 8192;
#pragma unroll
    for (int dt = 0; dt < 4; ++dt) { f32x4 acc = (f32x4){0.f, 0.f, 0.f, 0.f};
#pragma unroll
        for (int ks = 0; ks < 2; ++ks) acc = MFMA16(av[ks], frag_tr(Ks, ks * 32, 16 * dt, 72, lane), acc);
#pragma unroll
        for (int r = 0; r < 4; ++r) U[(16 * w + quad * 4 + r) * 64 + 16 * dt + l15] = acc[r]; }
    __syncthreads();
}
__device__ __forceinline__ void scan_phase(const Frame& F) {
    for (int gt = blockIdx.x * NTHR + threadIdx.x; gt < 98304; gt += gridDim.x * NTHR) {
        float S[8];
#pragma unroll
        for (int e = 0; e < 8; ++e) S[e] = 0.f;
        if (gt < 65536) {
            const int bh = gt >> 11, e2 = gt & 2047, v = e2 >> 4, d8 = (e2 & 15) * 8;
            const float gC = exp2f(log1pf(-exp2f(-5.0f - (float)(bh & 3))) * 1.4426950408889634f * 128.0f);
            const float* U = F.UR + (size_t)bh * 16 * 16384 + v * 128 + d8; bf16* Sp = F.SRET + (size_t)bh * 16 * 16384 + v * 128 + d8;
            for (int n0 = 0; n0 < 16; n0 += 4) { f32x4 u[4][2];
#pragma unroll
                for (int k = 0; k < 4; ++k) { u[k][0] = *(const f32x4*)(U + (size_t)(n0 + k) * 16384); u[k][1] = *(const f32x4*)(U + (size_t)(n0 + k) * 16384 + 4); }
#pragma unroll
                for (int k = 0; k < 4; ++k) { v4u o; o.x = pk2(S[0], S[1]); o.y = pk2(S[2], S[3]); o.z = pk2(S[4], S[5]); o.w = pk2(S[6], S[7]);
                    *(v4u*)(Sp + (size_t)(n0 + k) * 16384) = o;
#pragma unroll
                    for (int e = 0; e < 8; ++e) S[e] = gC * S[e] + u[k][e >> 2][e & 3]; } }
            float* so = F.out + O_SRP + (size_t)bh * 16384;
#pragma unroll
            for (int e = 0; e < 8; ++e) so[(d8 + e) * 128 + v] = S[e];
        } else {
            const int g2 = gt - 65536, bh = g2 >> 10, e2 = g2 & 1023, v = e2 >> 3, d8 = (e2 & 7) * 8;
            const float* U = F.UG + (size_t)bh * 32 * 8192 + v * 64 + d8; bf16* Sp = F.SGLA + (size_t)bh * 32 * 8192 + v * 64 + d8; const float* BLp = F.BL + (size_t)bh * 32 * 64 + d8;
            for (int n0 = 0; n0 < 32; n0 += 4) { f32x4 u[4][2], bl[4][2];
#pragma unroll
                for (int k = 0; k < 4; ++k) { u[k][0] = *(const f32x4*)(U + (size_t)(n0 + k) * 8192); u[k][1] = *(const f32x4*)(U + (size_t)(n0 + k) * 8192 + 4);
                    bl[k][0] = *(const f32x4*)(BLp + (n0 + k) * 64); bl[k][1] = *(const f32x4*)(BLp + (n0 + k) * 64 + 4); }
#pragma unroll
                for (int k = 0; k < 4; ++k) { v4u o; o.x = pk2(S[0], S[1]); o.y = pk2(S[2], S[3]); o.z = pk2(S[4], S[5]); o.w = pk2(S[6], S[7]);
                    *(v4u*)(Sp + (size_t)(n0 + k) * 8192) = o;
#pragma unroll
                    for (int e = 0; e < 8; ++e) S[e] = __expf(bl[k][e >> 2][e & 3]) * S[e] + u[k][e >> 2][e & 3]; } }
            float* so = F.out + O_SGP + (size_t)bh * 8192;
#pragma unroll
            for (int e = 0; e < 8; ++e) so[(d8 + e) * 128 + v] = S[e];
        }
    }
}
template <int DK, bool GLA> __device__ __forceinline__ void sample_pair(const Frame& F, int item0, LAS unsigned char* lds) {
    const int tt = threadIdx.x, half = tt >> 8, t = tt & 255, lane = t & 63, w = t >> 6;
    const int item = item0 + half, bs = item >> 2, h = item & 3;
    LAS float* qs = (LAS float*)(lds + half * 32768);
    LAS float* ks = qs + 8 * DK;
    LAS float* dc = ks + 8 * DK;
    LAS float* vs = dc + 8 * DK;
    LAS float* part = vs + 8 * 128;
    LAS float* lrs = part + 2 * 8 * 128;
    constexpr int DPT = DK / 2;
    const int v = t & 127, dq = t >> 7, d0 = dq * DPT;
    const float* S0 = (GLA ? F.st_gla : F.st_ret) + (size_t)(bs * 4 + h) * DK * 128;
    float S[DPT];
    { const float* sp = S0 + d0 * 128 + v;
#pragma unroll
      for (int i = 0; i < DPT; ++i) S[i] = __builtin_nontemporal_load(sp + i * 128); }
    const size_t row0 = (size_t)NTOKP + bs * 8;
    const int qcol = GLA ? C_QG + h * 64 : C_QR + h * 128, kcol = GLA ? C_KG + h * 64 : C_KR + h * 128;
    const int vcol = GLA ? C_VG + h * 128 : C_VR + h * 128, gcol = GLA ? C_GG + h * 128 : C_GR + h * 128;
    for (int idx = t; idx < 8 * DK; idx += 256) { const int tok = idx / DK, d = idx % DK;
        qs[idx] = bf2f(F.PROJ[(row0 + tok) * NPROJ + qcol + d]); ks[idx] = bf2f(F.PROJ[(row0 + tok) * NPROJ + kcol + d]); }
    for (int idx = t; idx < 8 * 128; idx += 256) { const int tok = idx >> 7, vv = idx & 127; vs[idx] = bf2f(F.PROJ[(row0 + tok) * NPROJ + vcol + vv]); }
    if (GLA) { if (t < 128) lrs[t] = bf2f(F.PROJ[(row0 + (t >> 4)) * NPROJ + C_LR + (t & 15)]); }
    __syncthreads();
    if (GLA) {
#pragma unroll
        for (int k2 = 0; k2 < 2; ++k2) { const int e = t + 256 * k2, tok = e >> 6, d = e & 63; float z = F.b_gk[h * 64 + d];
#pragma unroll
            for (int r = 0; r < 16; ++r) z += lrs[tok * 16 + r] * F.w_gk[r * 256 + h * 64 + d];
            dc[e] = __expf(logsig16(z)); }
        __syncthreads(); }
    const float gam = 1.0f - exp2f(-5.0f - (float)h);
#pragma unroll
    for (int tok = 0; tok < 8; ++tok) { const float vv = vs[tok * 128 + v]; float po = 0.f;
#pragma unroll
        for (int i4 = 0; i4 < DPT; i4 += 4) {
            const f32x4 kk = *(const LAS f32x4*)(ks + tok * DK + d0 + i4), qq = *(const LAS f32x4*)(qs + tok * DK + d0 + i4);
            f32x4 dd = (f32x4){gam, gam, gam, gam}; if (GLA) dd = *(const LAS f32x4*)(dc + tok * DK + d0 + i4);
#pragma unroll
            for (int e = 0; e < 4; ++e) { S[i4 + e] = dd[e] * S[i4 + e] + kk[e] * vv; po += qq[e] * S[i4 + e]; } }
        part[(dq * 8 + tok) * 128 + v] = po; }
    { float* So = F.out + (GLA ? O_SGS : O_SRS) + (size_t)(bs * 4 + h) * DK * 128 + d0 * 128 + v;
#pragma unroll
      for (int i = 0; i < DPT; ++i) __builtin_nontemporal_store(S[i], So + i * 128); }
    float gpre[2][2];
#pragma unroll
    for (int k2 = 0; k2 < 2; ++k2)
#pragma unroll
        for (int q = 0; q < 2; ++q) gpre[k2][q] = bf2f(F.PROJ[(row0 + 2 * w + k2) * NPROJ + gcol + lane + 64 * q]);
    __syncthreads();
    { const float* gain = (GLA ? F.gla_norm : F.ret_norm) + h * 128;
#pragma unroll
      for (int k2 = 0; k2 < 2; ++k2) { const int tok = 2 * w + k2; const size_t row = row0 + tok;
          float o[2];
#pragma unroll
          for (int q = 0; q < 2; ++q) { const int vv = lane + 64 * q; o[q] = part[(0 * 8 + tok) * 128 + vv] + part[(1 * 8 + tok) * 128 + vv]; }
          const float ss = wave_sum(o[0] * o[0] + o[1] * o[1]);
          const float rstd = rsqrtf(ss * (1.0f / 128.0f) + 1e-6f);
#pragma unroll
          for (int q = 0; q < 2; ++q) { const int vv = lane + 64 * q;
              F.MIX[row * DM + (GLA ? 512 : 0) + h * 128 + vv] = f2bf(o[q] * rstd * gain[vv] * silu_f(gpre[k2][q])); } } }
    __syncthreads();
}
__device__ __forceinline__ void ret_pass2(const Frame& F, int item, LAS unsigned char* lds) {
    const int b = item >> 6, h = (item >> 4) & 3, n = item & 15;
    const int t = threadIdx.x, lane = t & 63, w = __builtin_amdgcn_readfirstlane(t >> 6), l15 = lane & 15, quad = lane >> 4;
    LAS bf16* Qs = (LAS bf16*)lds; LAS bf16* Ks = Qs + 128 * 136; LAS bf16* Vt = Ks + 128 * 136; LAS bf16* St = Vt + 128 * 136;
    const size_t row0 = (size_t)b * 2048 + n * 128;
    v4u gt[4];
#pragma unroll
    for (int i = 0; i < 4; ++i) gt[i] = *(const v4u*)(F.PROJ + (row0 + 16 * (t >> 6) + (lane >> 4) + 4 * i) * NPROJ + C_GR + h * 128 + (lane & 15) * 8);
    tile_g2l<128, 16>(F.PROJ + row0 * NPROJ + C_QR + h * 128, NPROJ, Qs, 136);
    tile_g2l<128, 16>(F.PROJ + row0 * NPROJ + C_KR + h * 128, NPROJ, Ks, 136);
    tile_g2l<128, 16>(F.SRET + (size_t)((b * 4 + h) * 16 + n) * 16384, 128, St, 136);
    tile_g2l<128, 16>(F.PROJ + row0 * NPROJ + C_VR + h * 128, NPROJ, Vt, 136);
    __syncthreads();
    const float lg2 = log1pf(-exp2f(-5.0f - (float)h)) * 1.4426950408889634f;
    const int i0 = 16 * w;
    bf16x8 qa[4];
#pragma unroll
    for (int ks = 0; ks < 4; ++ks) qa[ks] = frag(Qs, i0 + l15, ks * 32 + quad * 8, 136);
    f32x4 acc[8];
#pragma unroll
    for (int vt = 0; vt < 8; ++vt) { acc[vt] = (f32x4){0.f, 0.f, 0.f, 0.f};
#pragma unroll
        for (int ks = 0; ks < 4; ++ks) acc[vt] = MFMA16(qa[ks], frag(St, 16 * vt + l15, ks * 32 + quad * 8, 136), acc[vt]); }
    { f32x4 sc;
#pragma unroll
      for (int r = 0; r < 4; ++r) sc[r] = __builtin_amdgcn_exp2f(lg2 * (float)(i0 + quad * 4 + r + 1));
#pragma unroll
      for (int vt = 0; vt < 8; ++vt) acc[vt] = acc[vt] * sc; }
    LAS bf16* At = Qs + i0 * 136;
    asm volatile("s_waitcnt lgkmcnt(0)" ::: "memory");
    const int njt = (w | 1) + 1;
    for (int jt = 0; jt < njt; ++jt) {
        f32x4 sv = (f32x4){0.f, 0.f, 0.f, 0.f};
        if (jt <= w) {
#pragma unroll
            for (int ks = 0; ks < 4; ++ks) sv = MFMA16(qa[ks], frag(Ks, 16 * jt + l15, ks * 32 + quad * 8, 136), sv); }
#pragma unroll
        for (int r = 0; r < 4; ++r) { const int diff = (i0 + quad * 4 + r) - (16 * jt + l15);
            const float val = diff >= 0 ? sv[r] * __builtin_amdgcn_exp2f(lg2 * (float)diff) : 0.f;
            At[(quad * 4 + r) * 136 + 16 * jt + l15] = f2bf(val); }
    }
    asm volatile("s_waitcnt lgkmcnt(0)" ::: "memory");
    const int nks = (w >> 1) + 1;
    for (int ks = 0; ks < nks; ++ks) { const bf16x8 aa = frag(At, l15, ks * 32 + quad * 8, 136);
#pragma unroll
        for (int vt = 0; vt < 8; ++vt) acc[vt] = MFMA16(aa, frag_tr(Vt, ks * 32, 16 * vt, 136, lane), acc[vt]); }
    f32x4 ss = (f32x4){0.f, 0.f, 0.f, 0.f};
#pragma unroll
    for (int vt = 0; vt < 8; ++vt) ss += acc[vt] * acc[vt];
#pragma unroll
    for (int r = 0; r < 4; ++r) { float v = ss[r]; v += __shfl_xor(v, 1); v += __shfl_xor(v, 2); v += __shfl_xor(v, 4); v += __shfl_xor(v, 8); ss[r] = rsqrtf(v * (1.0f / 128.0f) + 1e-6f); }
    __syncthreads();
    { LAS float* Ow = (LAS float*)(lds + 34816) + w * (16 * 132);
#pragma unroll
      for (int vt = 0; vt < 8; ++vt)
#pragma unroll
          for (int r = 0; r < 4; ++r) Ow[(quad * 4 + r) * 132 + 16 * vt + l15] = acc[vt][r] * ss[r];
      asm volatile("s_waitcnt lgkmcnt(0)" ::: "memory");
      const int c8 = (lane & 15) * 8;
      const f32x4 gn0 = *(const f32x4*)(F.ret_norm + h * 128 + c8), gn1 = *(const f32x4*)(F.ret_norm + h * 128 + c8 + 4);
#pragma unroll
      for (int i = 0; i < 4; ++i) { const int rr = (lane >> 4) + 4 * i;
          const f32x4 a = *(const LAS f32x4*)(Ow + rr * 132 + c8) * gn0, bq = *(const LAS f32x4*)(Ow + rr * 132 + c8 + 4) * gn1;
          v4u o; o.x = pk2(a[0] * silu_f(bf2f(gt[i].x & 0xffffu)), a[1] * silu_f(bf2f(gt[i].x >> 16))); o.y = pk2(a[2] * silu_f(bf2f(gt[i].y & 0xffffu)), a[3] * silu_f(bf2f(gt[i].y >> 16)));
          o.z = pk2(bq[0] * silu_f(bf2f(gt[i].z & 0xffffu)), bq[1] * silu_f(bf2f(gt[i].z >> 16))); o.w = pk2(bq[2] * silu_f(bf2f(gt[i].w & 0xffffu)), bq[3] * silu_f(bf2f(gt[i].w >> 16)));
          *(v4u*)(F.MIX + (row0 + i0 + rr) * DM + h * 128 + c8) = o; } }
    __syncthreads();
}
__device__ __forceinline__ void gla_pass2(const Frame& F, int item, LAS unsigned char* lds) {
    const int b = item >> 7, h = (item >> 5) & 3, n = item & 31;
    const int t = threadIdx.x, lane = t & 63, w = __builtin_amdgcn_readfirstlane(t >> 6), l15 = lane & 15, quad = lane >> 4;
    LAS bf16* Qs = (LAS bf16*)lds;
    LAS bf16* Ks = Qs + 64 * 72;
    LAS bf16* Vt = Ks + 64 * 72;
    LAS bf16* St = Vt + 64 * 136;
    LAS bf16* Aw = St + 128 * 72;
    LAS float* bcum = (LAS float*)(lds + 73728);
    LAS float* lrs = bcum + 4096;
    LAS float* tot = lrs + 1024;
    LAS float* ssx = tot + 512;
    const size_t row0 = (size_t)b * 2048 + n * 64;
    v4u gt[2];
#pragma unroll
    for (int i = 0; i < 2; ++i) gt[i] = *(const v4u*)(F.PROJ + (row0 + 16 * ((t >> 6) & 3) + (lane >> 3) + 8 * i) * NPROJ + C_GG + h * 128 + (t >> 8) * 64 + (lane & 7) * 8);
    tile_g2l<64, 16>(F.PROJ + row0 * NPROJ + C_VG + h * 128, NPROJ, Vt, 136);
    tile_g2l<128, 8>(F.SGLA + (size_t)((b * 4 + h) * 32 + n) * 8192, 64, St, 72);
    gla_gk_cumsum(F, h, row0, bcum, lrs, tot);
    { const int i = t >> 3, d8 = (t & 7) * 8;
      const v4u q = *(const v4u*)(F.PROJ + (row0 + i) * NPROJ + C_QG + h * 64 + d8), k = *(const v4u*)(F.PROJ + (row0 + i) * NPROJ + C_KG + h * 64 + d8);
      const f32x4 b0 = *(const LAS f32x4*)(bcum + i * 64 + d8), b1 = *(const LAS f32x4*)(bcum + i * 64 + d8 + 4);
      v4u qo, ko;
#pragma unroll
      for (int e = 0; e < 4; ++e) { const float ba = e < 2 ? b0[2 * e] : b1[2 * e - 4], bb = e < 2 ? b0[2 * e + 1] : b1[2 * e - 3];
          const float ea = __expf(ba), eb = __expf(bb);
          qo[e] = pk2(bf2f(q[e] & 0xffffu) * ea, bf2f(q[e] >> 16) * eb);
          ko[e] = pk2(bf2f(k[e] & 0xffffu) * __builtin_amdgcn_rcpf(ea), bf2f(k[e] >> 16) * __builtin_amdgcn_rcpf(eb)); }
      *(LAS v4u*)(Qs + i * 72 + d8) = qo; *(LAS v4u*)(Ks + i * 72 + d8) = ko; }
    __syncthreads();
    const int rt = w & 3, vh = w >> 2, i0 = 16 * rt;
    bf16x8 qa[2];
#pragma unroll
    for (int ks = 0; ks < 2; ++ks) qa[ks] = frag(Qs, i0 + l15, ks * 32 + quad * 8, 72);
    f32x4 acc[4];
#pragma unroll
    for (int v4 = 0; v4 < 4; ++v4) { acc[v4] = (f32x4){0.f, 0.f, 0.f, 0.f};
#pragma unroll
        for (int ks = 0; ks < 2; ++ks) acc[v4] = MFMA16(qa[ks], frag(St, 16 * (vh * 4 + v4) + l15, ks * 32 + quad * 8, 72), acc[v4]); }
    LAS bf16* At = Aw + w * 16 * 72;
    const int njt = (rt | 1) + 1;
    for (int jt = 0; jt < njt; ++jt) {
        f32x4 sv = (f32x4){0.f, 0.f, 0.f, 0.f};
        if (jt <= rt) {
#pragma unroll
            for (int ks = 0; ks < 2; ++ks) sv = MFMA16(qa[ks], frag(Ks, 16 * jt + l15, ks * 32 + quad * 8, 72), sv); }
#pragma unroll
        for (int r = 0; r < 4; ++r) { const int diff = (i0 + quad * 4 + r) - (16 * jt + l15);
            At[(quad * 4 + r) * 72 + 16 * jt + l15] = f2bf(diff >= 0 ? sv[r] : 0.f); }
    }
    asm volatile("s_waitcnt lgkmcnt(0)" ::: "memory");
    const int nks = (rt >> 1) + 1;
    for (int ks = 0; ks < nks; ++ks) { const bf16x8 aa = frag(At, l15, ks * 32 + quad * 8, 72);
#pragma unroll
        for (int v4 = 0; v4 < 4; ++v4) acc[v4] = MFMA16(aa, frag_tr(Vt, ks * 32, 16 * (vh * 4 + v4), 136, lane), acc[v4]); }
    f32x4 ss = (f32x4){0.f, 0.f, 0.f, 0.f};
#pragma unroll
    for (int v4 = 0; v4 < 4; ++v4) ss += acc[v4] * acc[v4];
#pragma unroll
    for (int r = 0; r < 4; ++r) { float v = ss[r]; v += __shfl_xor(v, 1); v += __shfl_xor(v, 2); v += __shfl_xor(v, 4); v += __shfl_xor(v, 8); ss[r] = v; }
    if (l15 == 0) { ssx[w * 16 + quad * 4 + 0] = ss[0]; ssx[w * 16 + quad * 4 + 1] = ss[1]; ssx[w * 16 + quad * 4 + 2] = ss[2]; ssx[w * 16 + quad * 4 + 3] = ss[3]; }
    __syncthreads();
#pragma unroll
    for (int r = 0; r < 4; ++r) ss[r] = rsqrtf((ssx[w * 16 + quad * 4 + r] + ssx[(w ^ 4) * 16 + quad * 4 + r]) * (1.0f / 128.0f) + 1e-6f);
    { LAS float* Ow = (LAS float*)lds + w * (16 * 68);
#pragma unroll
      for (int v4 = 0; v4 < 4; ++v4)
#pragma unroll
          for (int r = 0; r < 4; ++r) Ow[(quad * 4 + r) * 68 + 16 * v4 + l15] = acc[v4][r] * ss[r];
      asm volatile("s_waitcnt lgkmcnt(0)" ::: "memory");
      const int c8 = (lane & 7) * 8, hv = h * 128 + vh * 64 + c8;
      const f32x4 gn0 = *(const f32x4*)(F.gla_norm + hv), gn1 = *(const f32x4*)(F.gla_norm + hv + 4);
#pragma unroll
      for (int i = 0; i < 2; ++i) { const int rr = (lane >> 3) + 8 * i;
          const f32x4 a = *(const LAS f32x4*)(Ow + rr * 68 + c8) * gn0, bq = *(const LAS f32x4*)(Ow + rr * 68 + c8 + 4) * gn1;
          v4u o; o.x = pk2(a[0] * silu_f(bf2f(gt[i].x & 0xffffu)), a[1] * silu_f(bf2f(gt[i].x >> 16))); o.y = pk2(a[2] * silu_f(bf2f(gt[i].y & 0xffffu)), a[3] * silu_f(bf2f(gt[i].y >> 16)));
          o.z = pk2(bq[0] * silu_f(bf2f(gt[i].z & 0xffffu)), bq[1] * silu_f(bf2f(gt[i].z >> 16))); o.w = pk2(bq[2] * silu_f(bf2f(gt[i].w & 0xffffu)), bq[3] * silu_f(bf2f(gt[i].w >> 16)));
          *(v4u*)(F.MIX + (row0 + i0 + rr) * DM + 512 + hv) = o; } }
    __syncthreads();
}
#define XB_TMO      128
#define XB_XCNT(j)  (256  + 64 * (j))
#define XB_XSUB(j)  (1280 + 64 * (j))
#define XB_XGEN(j)  (2304 + 64 * (j))
#define XB_TOP      3328
#define XB_TOPGEN   3392
#define XCD_BAR_WORDS 3456
#define XB_SPIN_CAP (1u << 18)

__device__ __forceinline__ unsigned xb_ld(unsigned* p)              { return __hip_atomic_load(p, __ATOMIC_RELAXED, __HIP_MEMORY_SCOPE_AGENT); }
__device__ __forceinline__ unsigned xb_add(unsigned* p, unsigned v) { return __hip_atomic_fetch_add(p, v, __ATOMIC_RELAXED, __HIP_MEMORY_SCOPE_AGENT); }
__device__ __forceinline__ unsigned xb_xcc_id() { return (unsigned)__builtin_amdgcn_s_getreg((3 << 11) | 20) & 0xFu; }
#define XB_SPIN(cond, bar) do { unsigned _sp = 0; while (cond) { __builtin_amdgcn_s_sleep(1); \
    if ((++_sp & 255u) == 0u) { if (xb_ld(&(bar)[XB_TMO])) break; if (_sp > XB_SPIN_CAP) { atomicAdd(&(bar)[XB_TMO], 1u); break; } } } } while (0)

struct XcdBarrier {
    unsigned* bar; unsigned x;
    volatile LAS unsigned* st;
};

__device__ __forceinline__ XcdBarrier xcd_barrier_post(unsigned* bar, volatile LAS unsigned* st) {
    XcdBarrier b; b.bar = bar; b.x = xb_xcc_id(); b.st = st;
    if (threadIdx.x == 0) (void)xb_add(&bar[XB_XCNT(b.x)], 1u);
    return b;
}
__device__ __forceinline__ void xcd_barrier_complete(unsigned* bar, unsigned x, unsigned& nloc, unsigned& nx) {
    const unsigned G = gridDim.x * gridDim.y * gridDim.z;
    unsigned sum, cnt, mine, sp = 0u;
    for (;;) {
        sum = 0u; cnt = 0u; mine = 0u;
#pragma unroll
        for (unsigned j = 0; j < 16; ++j) { const unsigned c = xb_ld(&bar[XB_XCNT(j)]); sum += c; cnt += (c > 0u) ? 1u : 0u; mine = (j == x) ? c : mine; }
        if (sum == G) break;
        __builtin_amdgcn_s_sleep(1);
        if ((++sp & 255u) == 0u) { if (xb_ld(&bar[XB_TMO])) break; if (sp > XB_SPIN_CAP) { atomicAdd(&bar[XB_TMO], 1u); break; } }
    }
    nloc = mine > 0u ? mine : 1u; nx = cnt > 0u ? cnt : 1u;
}

__device__ __forceinline__ void xcd_barrier(const XcdBarrier& b) {
    asm volatile("s_waitcnt vmcnt(0)" ::: "memory");
    __syncthreads();
    if (threadIdx.x == 0) {
        unsigned* bar = b.bar;
        __builtin_amdgcn_s_waitcnt(0);
        unsigned nloc = b.st[0], nx = b.st[1];
        if (nloc == 0u) { xcd_barrier_complete(bar, b.x, nloc, nx); b.st[0] = nloc; b.st[1] = nx; }
        const unsigned old = xb_add(&bar[XB_XSUB(b.x)], 1u);
        const unsigned gen = old / nloc;
        if (old + 1u == (gen + 1u) * nloc) {
            __builtin_amdgcn_fence(__ATOMIC_RELEASE, "agent");
            asm volatile("s_waitcnt vmcnt(0)" ::: "memory");
            const unsigned og = xb_add(&bar[XB_TOP], 1u);
            const unsigned tg = og / nx;
            if (og + 1u == (tg + 1u) * nx) xb_add(&bar[XB_TOPGEN], 1u);
            else XB_SPIN(xb_ld(&bar[XB_TOPGEN]) == tg, bar);
            __builtin_amdgcn_fence(__ATOMIC_ACQUIRE, "agent");
            xb_add(&bar[XB_XGEN(b.x)], 1u);
            asm volatile("s_waitcnt vmcnt(0)" ::: "memory");
        } else {
            XB_SPIN(xb_ld(&bar[XB_XGEN(b.x)]) == gen, bar);
            __builtin_amdgcn_fence(__ATOMIC_ACQUIRE, "agent");
            asm volatile("s_waitcnt vmcnt(0)" ::: "memory");
        }
    }
    __syncthreads();
}
#ifndef MK_N_LAUNCHES
#define MK_N_LAUNCHES 1
#endif
constexpr int N_PHASES = 11;
#ifndef PROBE_PH
#define PROBE_PH (-1)
#define PROBE_REPS 1
#endif
struct Args { const float* in[19]; float* out; unsigned char* ws; int ph_lo, ph_hi; };
__global__ void __launch_bounds__(NTHR, 2) hybrid_fwd(Args a) {
    extern __shared__ __attribute__((aligned(16))) unsigned char lds_raw[];
    LAS unsigned char* lds = (LAS unsigned char*)lds_raw;
    cg::grid_group grid = cg::this_grid();
    if (a.ph_lo < 0) grid.sync();
    volatile LAS unsigned* misc = (volatile LAS unsigned*)(lds + LDS_BYTES - 64);
    if (threadIdx.x < 2) misc[threadIdx.x] = 0u;
    __syncthreads();
    XcdBarrier bar = xcd_barrier_post((unsigned*)a.ws, misc);
    Frame F;
    F.x_p = a.in[0]; F.x_s = a.in[1]; F.st_ret = a.in[2]; F.st_gla = a.in[3]; F.c_p = a.in[4]; F.c_s = a.in[5]; F.w_ada = a.in[6]; F.b_ada = a.in[7]; F.mix_norm = a.in[8];
    F.w_in = a.in[9]; F.w_gk = a.in[10]; F.b_gk = a.in[11]; F.ret_norm = a.in[12]; F.gla_norm = a.in[13]; F.w_out = a.in[14]; F.ffn_norm = a.in[15]; F.w_gu = a.in[16];
    F.w_dn = a.in[17]; F.fin_norm = a.in[18]; F.out = a.out; F.ws = a.ws;
    F.WIN = (bf16*)(a.ws + WS_WIN); F.WOUT = (bf16*)(a.ws + WS_WOUT); F.WGU = (bf16*)(a.ws + WS_WGU); F.WDN = (bf16*)(a.ws + WS_WDN);
    F.H = (bf16*)(a.ws + WS_H); F.MIX = (bf16*)(a.ws + WS_MIX); F.PROJ = (bf16*)(a.ws + WS_PROJ); F.HID = (bf16*)(a.ws + WS_HID);
    F.SRET = (bf16*)(a.ws + WS_SRET); F.SGLA = (bf16*)(a.ws + WS_SGLA);
    F.UR = a.out; F.UG = a.out + (size_t)512 * 16384; F.BL = (float*)(a.ws + WS_BL);
    F.MOD = (float*)(a.ws + WS_MOD); F.RC = (float*)(a.ws + WS_ROPE); F.RS = F.RC + ROPE_ROWS * 64;
    const int G = gridDim.x, bx = blockIdx.x, lo = a.ph_lo, hi = a.ph_hi;
#define IN(k) (lo <= (k) && (k) < hi)
#define SEAM(k) do { if (IN(k) && IN((k) + 1)) xcd_barrier(bar); } while (0)
#define RUN(k, BODY) do { if (IN(k)) { for (int rep = 0; rep < ((PROBE_PH == (k)) ? PROBE_REPS : 1); ++rep) { if (rep) xcd_barrier(bar); BODY; } } SEAM(k); } while (0)
#define PH0 p0_prologue(F, lds)
#define PH1 norm_phase<true>(F.x_p, F.x_s, F.mix_norm, F.MOD, 0, 1, F.H, nullptr, nullptr, 0, nullptr)
#define PH2 { pg8::Gemm g{F.H, F.WIN, NTOK, NPROJ, DM}; pg8::StaticOrder S; S.init(NTOK, NPROJ, G, bx, DM); pg8::EpiProj E{F.PROJ, F.RC, F.RS}; \
        pg8::gemm_phase<pg8::EpiProj, pg8::StaticOrder, true, true>(lds, g, S, E); }
#define PH3 { for (int it = bx; it < 1536; it += G) { if (it < 512) ret_u_item(F, it, lds); else gla_u_item(F, it - 512, lds); } \
        for (int j = bx; j < 512; j += G) { if (j < 256) sample_pair<128, false>(F, 2 * j, lds); else sample_pair<64, true>(F, 2 * (j - 256), lds); } }
#define PHSCAN scan_phase(F)
#define PH4 { for (int it = bx; it < 1536; it += G) { if (it < 512) ret_pass2(F, it, lds); else gla_pass2(F, it - 512, lds); } }
#define PH5 { pg8::Gemm g{F.MIX, F.WOUT, NTOK, DM, DM}; pg8::TailSplitOrder S; S.init(G, bx, DM, 8); pg8::EpiRes E{F.x_p, F.x_s, F.out, F.MOD + 2 * DM, (float*)(a.ws + WS_PART1)}; \
        pg8::gemm_phase<pg8::EpiRes, pg8::TailSplitOrder, true, true>(lds, g, S, E); }
#define PH6 norm_phase<true>(F.out, F.x_s, F.ffn_norm, F.MOD, 3, 4, F.H, F.out, (const float*)(a.ws + WS_PART1), 8, F.MOD + 2 * DM)
#define PH7 { pg8::Gemm g{F.H, F.WGU, NTOK, 2 * DFF, DM}; pg8::StaticOrder S; S.init(NTOK, 2 * DFF, G, bx, DM); pg8::EpiSwiGLU E{F.HID}; \
        pg8::gemm_phase<pg8::EpiSwiGLU, pg8::StaticOrder, true, true>(lds, g, S, E); }
#define PH8 { pg8::Gemm g{F.HID, F.WDN, NTOK, DM, DFF}; pg8::TailSplitOrder S; S.init(G, bx, DFF, 11); pg8::EpiRes E{F.out, F.out + (size_t)NTOKP * DM, F.out, F.MOD + 5 * DM, (float*)(a.ws + WS_PART2)}; \
        pg8::gemm_phase<pg8::EpiRes, pg8::TailSplitOrder, true, true>(lds, g, S, E); }
#define PH8D { pg8::Gemm g{F.HID, F.WDN, NTOK, DM, DFF}; pg8::TailSplitOrder S; S.init(G, bx, DFF, 11); pg8::EpiRes E{F.out, F.out + (size_t)NTOKP * DM, (float*)(a.ws + WS_H), F.MOD + 5 * DM, (float*)(a.ws + WS_PART2)}; \
        pg8::gemm_phase<pg8::EpiRes, pg8::TailSplitOrder, true, true>(lds, g, S, E); }
#define PH9 norm_phase<false>(F.out, F.out + (size_t)NTOKP * DM, F.fin_norm, nullptr, 0, 0, nullptr, F.out, (const float*)(a.ws + WS_PART2), 11, F.MOD + 5 * DM)
    RUN(0, PH0); RUN(1, PH1);
#ifdef PROBE_SYNCS
    for (int i = 0; i < PROBE_SYNCS; ++i) xcd_barrier(bar);
#endif
    RUN(2, PH2);
#ifdef PROBE_DUP2
    RUN(2, PH2);
#endif
#if defined(PROBE_DUP9)
    RUN(3, PH3); RUN(4, PHSCAN); RUN(5, PH4); RUN(6, PH5); RUN(7, PH6); RUN(8, PH7); RUN(9, PH8D); RUN(9, PH8); RUN(10, PH9);
#elif defined(PROBE_DUP6)
    RUN(3, PH3); RUN(4, PHSCAN); RUN(5, PH4); RUN(6, PH5); RUN(6, PH5); RUN(7, PH6); RUN(8, PH7); RUN(9, PH8); RUN(10, PH9);
#elif defined(PROBE_DUP8)
    RUN(3, PH3); RUN(4, PHSCAN); RUN(5, PH4); RUN(6, PH5); RUN(7, PH6); RUN(8, PH7); RUN(8, PH7); RUN(9, PH8); RUN(10, PH9);
#else
    RUN(3, PH3); RUN(4, PHSCAN); RUN(5, PH4); RUN(6, PH5); RUN(7, PH6); RUN(8, PH7); RUN(9, PH8); RUN(10, PH9);
#endif
}

extern "C" void kernel_launch(void* const* d_in, const int* in_sizes, int n_in, void* d_out, int out_size, void* d_ws, size_t ws_size, hipStream_t stream) {
    static int grid = 0;
    if (grid == 0) {
        int dev = 0, cus = 0, per_cu = 0;
        if (n_in != 19 || ws_size < WS_END) { fprintf(stderr, "kernel_launch: unexpected n_in %d / ws %zu\n", n_in, ws_size); grid = -1; return; }
        (void)hipGetDevice(&dev);
        (void)hipDeviceGetAttribute(&cus, hipDeviceAttributeMultiprocessorCount, dev);
        (void)hipFuncSetAttribute((const void*)hybrid_fwd, hipFuncAttributeMaxDynamicSharedMemorySize, LDS_BYTES);
        (void)hipOccupancyMaxActiveBlocksPerMultiprocessor(&per_cu, (const void*)hybrid_fwd, NTHR, LDS_BYTES);
        if (per_cu < 1) { fprintf(stderr, "kernel_launch: occupancy query reports %d blocks per CU\n", per_cu); grid = -1; return; }
        grid = cus;
        if (grid > 256) grid = 256;
    }
    if (grid < 0) return;
    (void)hipMemsetAsync(d_ws, 0, XCD_BAR_WORDS * 4, stream);
    Args a{};
    for (int i = 0; i < 19; ++i) a.in[i] = (const float*)d_in[i];
    a.out = (float*)d_out; a.ws = (unsigned char*)d_ws;
#if MK_N_LAUNCHES == 1
    a.ph_lo = 0; a.ph_hi = N_PHASES;
    void* args[] = {&a};
    hipError_t e = hipLaunchCooperativeKernel((void*)hybrid_fwd, dim3(grid), dim3(NTHR), args, LDS_BYTES, stream);
    if (e != hipSuccess) fprintf(stderr, "cooperative launch failed: %s (grid %d)\n", hipGetErrorString(e), grid);
#else
    for (int p = 0; p < N_PHASES; ++p) { a.ph_lo = p; a.ph_hi = p + 1; hipLaunchKernelGGL(hybrid_fwd, dim3(grid), dim3(NTHR), LDS_BYTES, stream, a); }
#endif
}
```
